# Optimizing an MI355X kernel written in HIP

```python
import math
import jax, jax.numpy as jnp
from jax import lax
import numpy as np

D_MODEL = 2048
BATCH = 2
SEQ = 8192
DEPTH = 1

D_MIX = D_MODEL
D_LRU = D_MIX // 2
D_SC = D_MIX - D_LRU
N_LRU_HEADS = 8
LRU_HEAD_DIM = D_LRU // N_LRU_HEADS
N_SC_HEADS = 8
LRU_CONV_WIDTH = 4
SC_CONV_WIDTH = 3
LRU_C = 8.0
D_FF = 5632
FFN_RESIDUAL_SCALE = 0.5
NORM_EPS = 1e-6
D_IN_PROJ = 2 * D_LRU + 3 * D_SC

kernel_name = "hawk_shortconv_macaron_hybrid"


def rms_norm(x, gain):
    xf = x.astype(jnp.float32)
    var = jnp.mean(xf * xf, axis=-1, keepdims=True)
    return (xf * lax.rsqrt(var + NORM_EPS) * gain.astype(jnp.float32)).astype(x.dtype)


def swiglu_ffn(x, w_gate, w_up, w_down):
    return (jax.nn.silu(x @ w_gate) * (x @ w_up)) @ w_down


def causal_depthwise_conv(x, w):
    K = w.shape[0]
    S = x.shape[1]
    xp = jnp.pad(x, ((0, 0), (K - 1, 0), (0, 0)))
    y = xp[:, 0:S] * w[0]
    for k in range(1, K):
        y = y + xp[:, k:k + S] * w[k]
    return y


def _lru_combine(left, right):
    a_l, b_l = left
    a_r, b_r = right
    return a_l * a_r, a_r * b_l + b_r


def rg_lru(x, w_a, b_a, w_i, b_i, lam):
    Bsz, S, W = x.shape
    xh = x.reshape(Bsz, S, N_LRU_HEADS, LRU_HEAD_DIM)
    r = jax.nn.sigmoid(jnp.einsum('bshi,hij->bshj', xh, w_a) + b_a).reshape(Bsz, S, W)
    i = jax.nn.sigmoid(jnp.einsum('bshi,hij->bshj', xh, w_i) + b_i).reshape(Bsz, S, W)
    log_a = -LRU_C * r.astype(jnp.float32) * jax.nn.softplus(-lam.astype(jnp.float32))
    a = jnp.exp(log_a)
    mult = jnp.sqrt(-jnp.expm1(2.0 * log_a))
    u = mult * (i * x).astype(jnp.float32)
    _, h = lax.associative_scan(_lru_combine, (a, u), axis=1)
    return h.astype(x.dtype)


def setup_inputs(seed: int = 0) -> dict:
    key = jax.random.key(seed)
    ks = jax.random.split(key, 32)
    f32 = jnp.float32

    def normal(k, shape, fan_in):
        return jax.random.normal(k, shape, f32) * (fan_in ** -0.5)

    def gain(k, shape):
        return 1.0 + 0.02 * jax.random.normal(k, shape, f32)

    def small(k, shape):
        return 0.01 * jax.random.normal(k, shape, f32)

    L = DEPTH
    a0 = jax.random.uniform(ks[13], (L, D_LRU), f32, 0.9, 0.999) ** (1.0 / LRU_C)
    lru_lambda = jnp.log(a0) - jnp.log1p(-a0)
    return {
        "x": jax.random.normal(ks[0], (BATCH, SEQ, D_MODEL), f32),
        "ffn1_norm": gain(ks[1], (L, D_MODEL)),
        "ffn1_w_gate": normal(ks[2], (L, D_MODEL, D_FF), D_MODEL),
        "ffn1_w_up": normal(ks[3], (L, D_MODEL, D_FF), D_MODEL),
        "ffn1_w_down": normal(ks[4], (L, D_FF, D_MODEL), D_FF),
        "mix_norm": gain(ks[5], (L, D_MODEL)),
        "w_in": normal(ks[6], (L, D_MODEL, D_IN_PROJ), D_MODEL),
        "lru_conv_w": normal(ks[7], (L, LRU_CONV_WIDTH, D_LRU), LRU_CONV_WIDTH),
        "lru_conv_b": small(ks[8], (L, D_LRU)),
        "lru_w_a": normal(ks[9], (L, N_LRU_HEADS, LRU_HEAD_DIM, LRU_HEAD_DIM), LRU_HEAD_DIM),
        "lru_b_a": small(ks[10], (L, N_LRU_HEADS, LRU_HEAD_DIM)),
        "lru_w_i": normal(ks[11], (L, N_LRU_HEADS, LRU_HEAD_DIM, LRU_HEAD_DIM), LRU_HEAD_DIM),
        "lru_b_i": small(ks[12], (L, N_LRU_HEADS, LRU_HEAD_DIM)),
        "lru_lambda": lru_lambda,
        "sc_conv_w": normal(ks[14], (L, SC_CONV_WIDTH, D_SC), SC_CONV_WIDTH),
        "lru_out_norm": gain(ks[15], (L, D_LRU)),
        "sc_out_norm": gain(ks[16], (L, D_SC)),
        "w_out": normal(ks[17], (L, D_MIX, D_MODEL), D_MIX),
        "ffn2_norm": gain(ks[18], (L, D_MODEL)),
        "ffn2_w_gate": normal(ks[19], (L, D_MODEL, D_FF), D_MODEL),
        "ffn2_w_up": normal(ks[20], (L, D_MODEL, D_FF), D_MODEL),
        "ffn2_w_down": normal(ks[21], (L, D_FF, D_MODEL), D_FF),
        "final_norm": gain(ks[22], (D_MODEL,)),
    }


def reference(x, ffn1_norm, ffn1_w_gate, ffn1_w_up, ffn1_w_down, mix_norm, w_in,
              lru_conv_w, lru_conv_b, lru_w_a, lru_b_a, lru_w_i, lru_b_i, lru_lambda,
              sc_conv_w, lru_out_norm, sc_out_norm, w_out,
              ffn2_norm, ffn2_w_gate, ffn2_w_up, ffn2_w_down, final_norm):
    for l in range(DEPTH):
        x = x + FFN_RESIDUAL_SCALE * swiglu_ffn(rms_norm(x, ffn1_norm[l]),
                                                ffn1_w_gate[l], ffn1_w_up[l], ffn1_w_down[l])
        z = rms_norm(x, mix_norm[l]) @ w_in[l]
        o = 0
        lru_x = z[..., o:o + D_LRU]; o += D_LRU
        lru_gate = z[..., o:o + D_LRU]; o += D_LRU
        sc_b = z[..., o:o + D_SC]; o += D_SC
        sc_c = z[..., o:o + D_SC]; o += D_SC
        sc_x = z[..., o:o + D_SC]
        xc = causal_depthwise_conv(lru_x, lru_conv_w[l]) + lru_conv_b[l]
        h = rg_lru(xc, lru_w_a[l], lru_b_a[l], lru_w_i[l], lru_b_i[l], lru_lambda[l])
        y_lru = h * jax.nn.gelu(lru_gate, approximate=True)
        y_sc = sc_b * causal_depthwise_conv(sc_c * sc_x, sc_conv_w[l])
        y = jnp.concatenate([rms_norm(y_lru, lru_out_norm[l]),
                             rms_norm(y_sc, sc_out_norm[l])], axis=-1)
        x = x + y @ w_out[l]
        x = x + FFN_RESIDUAL_SCALE * swiglu_ffn(rms_norm(x, ffn2_norm[l]),
                                                ffn2_w_gate[l], ffn2_w_up[l], ffn2_w_down[l])
    return rms_norm(x, final_norm)
```

```cpp
#include <hip/hip_runtime.h>
#include <hip/hip_cooperative_groups.h>
#include <cstdio>
#include <cstdint>
namespace cg = cooperative_groups;

#define LAS __attribute__((address_space(3)))
#define GAS __attribute__((address_space(1)))
typedef unsigned short bf16_t;
typedef short bf16x8 __attribute__((ext_vector_type(8)));
typedef float f32x4 __attribute__((ext_vector_type(4)));
typedef float f32x2 __attribute__((ext_vector_type(2)));
typedef unsigned u32x4 __attribute__((ext_vector_type(4)));
typedef unsigned u32x2 __attribute__((ext_vector_type(2)));

constexpr int M = 16384, D = 2048, FF = 5632, DIN = 5120, DL = 1024, SEQ = 8192, CHUNK = 64, NCHUNK = M / CHUNK, CPB = SEQ / CHUNK;
constexpr float EPS = 1e-6f;
constexpr int GATE_K = 128;
constexpr size_t MiB = 1u << 20;
constexpr size_t WS_SS = 0;
constexpr size_t WS_AT = 1 * MiB, WS_HE = 2 * MiB;
constexpr size_t WS_BAR = 3 * MiB + 65536, BAR_BYTES = 16384;
constexpr size_t WS_SP = 3 * MiB;
constexpr size_t WS_WGU = 4 * MiB, WS_WD = 48 * MiB, WS_WIN = 70 * MiB, WS_WOUT = 90 * MiB, WS_WG = 98 * MiB;
constexpr size_t WS_XB = 100 * MiB;
constexpr size_t WS_U = 164 * MiB, WS_XC = 196 * MiB, WS_Y = 228 * MiB, WS_HZ = 292 * MiB, WS_LA = 468 * MiB, WS_END = 500 * MiB;
constexpr int P7_CST_OFF = 133120, LDS_BYTES = P7_CST_OFF + 5 * 1024 * 4 + 64;
constexpr bool EPI_ALIGN = true;
#define REPV {1, 1, 1, 1, 1, 1, 1, 1, 1, 1, 1, 1}
constexpr int REP_[12] = REPV;

__device__ __forceinline__ unsigned cvt_pk_bf16(float lo, float hi) { unsigned r; asm volatile("v_cvt_pk_bf16_f32 %0, %1, %2" : "=v"(r) : "v"(lo), "v"(hi)); return r; }
__device__ __forceinline__ float bf_lo(unsigned w) { return __uint_as_float(w << 16); }
__device__ __forceinline__ float bf_hi(unsigned w) { return __uint_as_float(w & 0xffff0000u); }
__device__ __forceinline__ float sigmoidf_(float x) { return __builtin_amdgcn_rcpf(1.0f + __expf(-x)); }
__device__ __forceinline__ float gelu_tanh(float x) {
    const float v = 0.7978845608028654f * (x + 0.044715f * x * x * x);
    const float e = __expf(2.0f * v);
    const float th = 1.0f - 2.0f * __builtin_amdgcn_rcpf(e + 1.0f);
    return 0.5f * x * (1.0f + th);
}
__device__ __forceinline__ float wave_sum(float v) {
#pragma unroll
    for (int o = 1; o < 64; o <<= 1) v += __shfl_xor(v, o);
    return v;
}
__device__ __forceinline__ int opaque_s(int v) { if (v != 1) asm volatile("" : "+s"(v)); return v; }
#define PHASE_IDS int tid = threadIdx.x; asm volatile("" : "+v"(tid)); const int lane = tid & 63, wave = __builtin_amdgcn_readfirstlane(tid >> 6), gw = blockIdx.x * 8 + wave, gt = blockIdx.x * 512 + tid; (void)lane; (void)gw; (void)gt; LAS float* scr = (LAS float*)(lds + wave * TR_SCR); (void)scr;
#define LDS_WAIT() asm volatile("s_waitcnt lgkmcnt(0)" ::: "memory")

namespace pg8 {
constexpr int BM = 256, BK = 64, HALF = 128, HTB = HALF * BK * 2, STAGE_BYTES = 8 * HTB, NXCD = 8, WGM = 4;
__host__ __device__ __forceinline__ int lds_byte(int r, int c) { const int st = (r >> 4) * 2 + (c >> 5), rr = r & 15, cc = c & 31, ob = rr * 64 + cc * 2; return st * 1024 + (ob ^ (((ob >> 9) & 1) << 5)); }
__host__ __device__ __forceinline__ void stage_rc(int b, int& R, int& C) { const int st = b / 1024, sb = b % 1024, swz = sb ^ (((sb >> 9) & 1) << 5); R = (st >> 1) * 16 + swz / 64; C = (st & 1) * 32 + (swz % 64) / 2; }
__host__ __device__ __forceinline__ int perm32(int rho) { const int n = rho >> 4, i = rho & 15; return 8 * (i >> 2) + 4 * n + (i & 3); }

struct Unit { int pm, pn; };
struct Gemm { const bf16_t* A; const bf16_t* Bt; int M, N, K, lda, ldb, a_pn_bytes; };

struct StaticOrder {
    int nM, nN, nwg, G, c, lo, hi;
    __host__ __device__ void init(int M_, int N_, int G_, int c_) { nM = M_ / BM; nN = N_ / BM; nwg = nM * nN; G = G_; c = c_; lo = 0; hi = 0x7fffffff; }
    __host__ __device__ bool next(int i, Unit& u) const {
        const long L = (long)i * G + c; if (i >= hi || L >= nwg) return false;
        int wgid = (int)L; { const int q = nwg / NXCD, r = nwg % NXCD, xcd = wgid % NXCD, off = wgid / NXCD; wgid = (xcd < r ? xcd * (q + 1) : r * (q + 1) + (xcd - r) * q) + off; }
        const int nig = WGM * nN, gid = wgid / nig, fm = gid * WGM, gsz = (nM - fm) < WGM ? (nM - fm) : WGM;
        u.pm = fm + ((wgid % nig) % gsz); u.pn = (wgid % nig) / gsz; return true;
    }
};


struct EpiSwiglu {
    static constexpr bool PREF = true;
    __device__ __forceinline__ void pre(float (&sv)[8], const Unit& u, int wr, int fr) const { const int row0 = u.pm * BM + wr * 64 + fr;
_Pragma("unroll") for (int i = 0; i < 8; ++i) sv[i] = ss[row0 + (i >> 2) * HALF + (i & 3) * 16]; }
    bf16_t* H; const float* ss;
    __device__ __forceinline__ void operator()(const f32x4 (&acc)[2][2][4][2], const Unit& u, int wr, int wc, int fr, int fq, const float (&sv)[8]) const {
        const int row0 = u.pm * BM + wr * 64 + fr, col0 = u.pn * 128 + wc * 32 + 8 * fq;
#pragma unroll
        for (int ai = 0; ai < 2; ++ai)
#pragma unroll
            for (int m = 0; m < 4; ++m) {
                const int row = row0 + ai * HALF + m * 16;
                const float var = sv[ai * 4 + m] * (1.0f / D) + EPS;
                const float c1 = -1.4426950408889634f * __builtin_amdgcn_rsqf(var);
                f32x2 hh[4];
#pragma unroll
                for (int p = 0; p < 4; ++p) {
                    const f32x2 g = (f32x2){acc[ai][0][m][p >> 1][(p & 1) * 2], acc[ai][0][m][p >> 1][(p & 1) * 2 + 1]};
                    const f32x2 up = (f32x2){acc[ai][1][m][p >> 1][(p & 1) * 2], acc[ai][1][m][p >> 1][(p & 1) * 2 + 1]};
                    const f32x2 t = g * c1; f32x2 d; d.x = __builtin_amdgcn_exp2f(t.x); d.y = __builtin_amdgcn_exp2f(t.y); d = d * var + var;
                    f32x2 r; r.x = __builtin_amdgcn_rcpf(d.x); r.y = __builtin_amdgcn_rcpf(d.y);
                    hh[p] = (g * up) * r;
                }
                u32x4 w; w.x = cvt_pk_bf16(hh[0].x, hh[0].y); w.y = cvt_pk_bf16(hh[1].x, hh[1].y); w.z = cvt_pk_bf16(hh[2].x, hh[2].y); w.w = cvt_pk_bf16(hh[3].x, hh[3].y);
                *(u32x4*)(H + (size_t)row * FF + col0) = w;
            }
    }
};
struct EpiResid {
    static constexpr bool PREF = false;
    const float* base; const bf16_t* bbase; bf16_t* xb; float* ss; float scale;
    __device__ __forceinline__ void operator()(const f32x4 (&acc)[2][2][4][2], const Unit& u, int wr, int wc, int fr, int fq, const float (&)[8]) const {
        const int row0 = u.pm * BM + wr * 64 + fr, col0 = u.pn * BM + wc * 32 + 8 * fq;
        u32x4 bw[2][2][2];
#define RES_LOAD(c, buf) _Pragma("unroll") for (int mi = 0; mi < 2; ++mi) _Pragma("unroll") for (int bj = 0; bj < 2; ++bj) \
            bw[buf][mi][bj] = *(const u32x4*)(bbase + (size_t)(row0 + ((c) >> 1) * HALF + (((c) & 1) * 2 + mi) * 16) * D + col0 + bj * HALF)
        RES_LOAD(0, 0);
#pragma unroll
        for (int c = 0; c < 4; ++c) {
            if (c < 3) { RES_LOAD(c + 1, (c + 1) & 1); }
            const int ai = c >> 1;
#pragma unroll
            for (int mi = 0; mi < 2; ++mi) {
                const int m = (c & 1) * 2 + mi, row = row0 + ai * HALF + m * 16; float s = 0.f;
#pragma unroll
                for (int bj = 0; bj < 2; ++bj) {
                    const size_t off = (size_t)row * D + col0 + bj * HALF; const u32x4 r = bw[c & 1][mi][bj];
                    const f32x4 o0 = (f32x4){bf_lo(r.x), bf_hi(r.x), bf_lo(r.y), bf_hi(r.y)} + acc[ai][bj][m][0] * scale, o1 = (f32x4){bf_lo(r.z), bf_hi(r.z), bf_lo(r.w), bf_hi(r.w)} + acc[ai][bj][m][1] * scale;
                    u32x4 w; w.x = cvt_pk_bf16(o0[0], o0[1]); w.y = cvt_pk_bf16(o0[2], o0[3]); w.z = cvt_pk_bf16(o1[0], o1[1]); w.w = cvt_pk_bf16(o1[2], o1[3]); *(u32x4*)(xb + off) = w;
                    s += (o0[0] * o0[0] + o0[1] * o0[1]) + (o0[2] * o0[2] + o0[3] * o0[3]) + (o1[0] * o1[0] + o1[1] * o1[1]) + (o1[2] * o1[2] + o1[3] * o1[3]);
                }
                s += __shfl_xor(s, 16); s += __shfl_xor(s, 32);
                if (fq == 0) atomicAdd(ss + row, s);
            }
        }
#undef RES_LOAD
    }
};
struct EpiZ {
    static constexpr bool PREF = true;
    __device__ __forceinline__ void pre(float (&sv)[8], const Unit& u, int wr, int fr) const { const int row0 = u.pm * BM + wr * 64 + fr;
_Pragma("unroll") for (int i = 0; i < 8; ++i) sv[i] = ss[row0 + (i >> 2) * HALF + (i & 3) * 16]; }
    bf16_t* Z; const float* ss;
    __device__ __forceinline__ void operator()(const f32x4 (&acc)[2][2][4][2], const Unit& u, int wr, int wc, int fr, int fq, const float (&sv)[8]) const {
        const int row0 = u.pm * BM + wr * 64 + fr, col0 = u.pn * BM + wc * 32 + 8 * fq;
        const bool prod = u.pn >= 12, gate = (u.pn >= 4 && u.pn < 8); const int colp = 3 * DL + (u.pn - 12) * 128 + wc * 32 + 8 * fq;
#pragma unroll
        for (int ai = 0; ai < 2; ++ai)
#pragma unroll
            for (int m = 0; m < 4; ++m) {
                const int row = row0 + ai * HALF + m * 16;
                const float rstd = __builtin_amdgcn_rsqf(sv[ai * 4 + m] * (1.0f / D) + EPS);
                if (prod) {
                    const float r2 = rstd * rstd;
                    const f32x4 v0 = acc[ai][0][m][0] * acc[ai][1][m][0] * r2, v1 = acc[ai][0][m][1] * acc[ai][1][m][1] * r2;
                    u32x4 w; w.x = cvt_pk_bf16(v0[0], v0[1]); w.y = cvt_pk_bf16(v0[2], v0[3]); w.z = cvt_pk_bf16(v1[0], v1[1]); w.w = cvt_pk_bf16(v1[2], v1[3]);
                    *(u32x4*)(Z + (size_t)row * DIN + colp) = w;
                } else {
#pragma unroll
                    for (int bj = 0; bj < 2; ++bj) {
                        f32x4 v0 = acc[ai][bj][m][0] * rstd, v1 = acc[ai][bj][m][1] * rstd;
                        if (gate) {
#pragma unroll
                            for (int e = 0; e < 4; ++e) { v0[e] = gelu_tanh(v0[e]); v1[e] = gelu_tanh(v1[e]); } }
                        u32x4 w; w.x = cvt_pk_bf16(v0[0], v0[1]); w.y = cvt_pk_bf16(v0[2], v0[3]); w.z = cvt_pk_bf16(v1[0], v1[1]); w.w = cvt_pk_bf16(v1[2], v1[3]);
                        *(u32x4*)(Z + (size_t)row * DIN + col0 + bj * HALF) = w;
                    }
                }
            }
    }
};
struct EpiGates {
    static constexpr bool PREF = false;
    const bf16_t* XC; bf16_t* LAout; bf16_t* Uout; const float* ba; const float* bi; const float* sp; float* AT; float* HE;
    __device__ __forceinline__ void operator()(const f32x4 (&acc)[2][2][4][2], const Unit& u, int wr, int wc, int fr, int fq, const float (&sv)[8]) const {
        const int rowb = u.pm * BM + wr * 64, ch0 = u.pn * 128 + wc * 32 + 8 * fq;
        float vba[8], vbi[8], sp8[8];
#pragma unroll
        for (int e = 0; e < 8; ++e) { vba[e] = ba[ch0 + e]; vbi[e] = bi[ch0 + e]; sp8[e] = sp[ch0 + e]; }
        u32x4 xws[8];
#pragma unroll
        for (int i = 0; i < 8; ++i) xws[i] = *(const u32x4*)(XC + (size_t)(rowb + (i >> 2) * HALF + 4 * fr + (i & 3)) * DL + ch0);
#pragma unroll
        for (int ai = 0; ai < 2; ++ai) {
            float Pc[8], Hc[8];
#pragma unroll
            for (int m = 0; m < 4; ++m) {
                const int row = rowb + ai * HALF + 4 * fr + m; const size_t off = (size_t)row * DL + ch0;
                const u32x4 xw = xws[ai * 4 + m];
                float xc[8] = {bf_lo(xw.x), bf_hi(xw.x), bf_lo(xw.y), bf_hi(xw.y), bf_lo(xw.z), bf_hi(xw.z), bf_lo(xw.w), bf_hi(xw.w)};
                float av[8], uv[8];
#pragma unroll
                for (int e = 0; e < 8; ++e) {
                    const float r = sigmoidf_(acc[ai][0][m][e >> 2][e & 3] + vba[e]), ig = sigmoidf_(acc[ai][1][m][e >> 2][e & 3] + vbi[e]);
                    av[e] = r * sp8[e];
                    uv[e] = ig * xc[e];
                }
                u32x4 wa; wa.x = cvt_pk_bf16(av[0], av[1]); wa.y = cvt_pk_bf16(av[2], av[3]); wa.z = cvt_pk_bf16(av[4], av[5]); wa.w = cvt_pk_bf16(av[6], av[7]); *(u32x4*)(LAout + off) = wa;
                const float ar[8] = {bf_lo(wa.x), bf_hi(wa.x), bf_lo(wa.y), bf_hi(wa.y), bf_lo(wa.z), bf_hi(wa.z), bf_lo(wa.w), bf_hi(wa.w)};
                float aa[8];
#pragma unroll
                for (int e = 0; e < 8; ++e) {
                    aa[e] = __builtin_amdgcn_exp2f(ar[e]);
                    uv[e] *= __builtin_amdgcn_sqrtf(fmaxf(1.0f - aa[e] * aa[e], 0.f));
                }
                u32x4 w; w.x = cvt_pk_bf16(uv[0], uv[1]); w.y = cvt_pk_bf16(uv[2], uv[3]); w.z = cvt_pk_bf16(uv[4], uv[5]); w.w = cvt_pk_bf16(uv[6], uv[7]);
                *(u32x4*)(Uout + off) = w;
                const float ur[8] = {bf_lo(w.x), bf_hi(w.x), bf_lo(w.y), bf_hi(w.y), bf_lo(w.z), bf_hi(w.z), bf_lo(w.w), bf_hi(w.w)};
#pragma unroll
                for (int e = 0; e < 8; ++e) { const float a = aa[e];
                    if (m == 0) { Pc[e] = a; Hc[e] = ur[e]; } else { Hc[e] = a * Hc[e] + ur[e]; Pc[e] *= a; } }
            }
#pragma unroll
            for (int sft = 1; sft < 16; sft <<= 1)
#pragma unroll
                for (int e = 0; e < 8; ++e) { const float Pn = __shfl_down(Pc[e], sft, 16), Hn = __shfl_down(Hc[e], sft, 16); Hc[e] = Pn * Hc[e] + Hn; Pc[e] *= Pn; }
            if (fr == 0) { const size_t so = (size_t)((rowb + ai * HALF) >> 6) * DL + ch0;
                *(f32x4*)(AT + so) = (f32x4){Pc[0], Pc[1], Pc[2], Pc[3]}; *(f32x4*)(AT + so + 4) = (f32x4){Pc[4], Pc[5], Pc[6], Pc[7]};
                *(f32x4*)(HE + so) = (f32x4){Hc[0], Hc[1], Hc[2], Hc[3]}; *(f32x4*)(HE + so + 4) = (f32x4){Hc[4], Hc[5], Hc[6], Hc[7]}; }
        }
    }
};

template <class Epi, bool ALIGN_EPI, bool APERM = false>
__device__ __forceinline__ void gemm_phase(LAS unsigned char* lds, const Gemm g, const StaticOrder& S, const Epi& E) {
    int tid_ = threadIdx.x; asm volatile("" : "+v"(tid_));
    const int tid = tid_, wid = __builtin_amdgcn_readfirstlane(tid >> 6), lane = tid & 63, wr = wid >> 2, wc = wid & 3, fr = lane & 15, fq = lane >> 4;
    int K_ = g.K; asm volatile("" : "+s"(K_));
    const int K = K_, nt = K / BK;
    unsigned voffA[2], voffB[2];
#pragma unroll
    for (int i = 0; i < 2; ++i) { int R, C; stage_rc(tid * 16 + i * 8192, R, C); const int Rb = (R & ~31) + perm32(R & 31);
        const int Ra = APERM ? ((R & ~63) + 4 * (R & 15) + ((R & 63) >> 4)) : R;
        voffA[i] = (unsigned)(Ra * g.lda + C) * 2u; voffB[i] = (unsigned)(Rb * g.ldb + C) * 2u; }
    const size_t kstep = (size_t)(BK * 2);
    const size_t hstepA = (size_t)HALF * g.lda * 2, hstepB = (size_t)HALF * g.ldb * 2;
    const size_t tstepA = 2 * hstepA, tstepB = 2 * hstepB;
    const unsigned ldsw = (unsigned)wid * 1024u;
    const int aoff = lds_byte(wr * 64 + fr, fq * 8), boff = lds_byte(wc * 32 + fr, fq * 8);
#define PG8_SA(b, h) (((b) * 2 + (h)) * HTB)
#define PG8_SB(b, h) ((4 + (b) * 2 + (h)) * HTB)
#define PG8_STAGE(bufoff, gbase, voff) do { _Pragma("unroll") for (int _i = 0; _i < 2; ++_i) \
        __builtin_amdgcn_global_load_lds((const unsigned*)((const char*)(gbase) + (voff)[_i]), (LAS unsigned*)(lds + (bufoff) + ldsw + _i * 8192), 16, 0, 0); } while (0)
#define PG8_LDA(dst, b, h) do { _Pragma("unroll") for (int m = 0; m < 4; ++m) _Pragma("unroll") for (int k = 0; k < 2; ++k) dst[m][k] = *(const LAS bf16x8*)(lds + PG8_SA(b, h) + aoff + m * 2048 + k * 1024); } while (0)
#define PG8_LDB(dst, b, h) do { _Pragma("unroll") for (int n = 0; n < 2; ++n) _Pragma("unroll") for (int k = 0; k < 2; ++k) dst[n][k] = *(const LAS bf16x8*)(lds + PG8_SB(b, h) + boff + n * 2048 + k * 1024); } while (0)
#define PG8_MMA(ai, bj, At, Bt) do { __builtin_amdgcn_s_setprio(1); _Pragma("unroll") for (int m = 0; m < 4; ++m) _Pragma("unroll") for (int n = 0; n < 2; ++n) _Pragma("unroll") for (int k = 0; k < 2; ++k) \
        acc[ai][bj][m][n] = __builtin_amdgcn_mfma_f32_16x16x32_bf16(Bt[n][k], At[m][k], acc[ai][bj][m][n], 0, 0, 0); __builtin_amdgcn_s_setprio(0); } while (0)
#define PG8_WAIT_V(n) asm volatile("s_waitcnt vmcnt(" #n ")" ::: "memory")
#define PG8_WAIT_L(n) asm volatile("s_waitcnt lgkmcnt(" #n ")" ::: "memory")
#define PG8_BAR __builtin_amdgcn_s_barrier()
#define PG8_SCHED __builtin_amdgcn_sched_barrier(0)
    Unit cur, nxt; int ui = S.lo;
    if (!S.next(ui, cur)) return;
    f32x4 acc[2][2][4][2];
#pragma unroll
    for (int a = 0; a < 2; ++a)
#pragma unroll
        for (int b = 0; b < 2; ++b)
#pragma unroll
            for (int m = 0; m < 4; ++m)
#pragma unroll
                for (int n = 0; n < 2; ++n) acc[a][b][m][n] = (f32x4){0.f, 0.f, 0.f, 0.f};
    bf16x8 At[4][2], B0[2][2], B1[2][2];
    float sv[8] = {0.f, 0.f, 0.f, 0.f, 0.f, 0.f, 0.f, 0.f};
    const char* cA = (const char*)g.A + (size_t)cur.pm * tstepA + (size_t)cur.pn * g.a_pn_bytes; const char* cB = (const char*)g.Bt + (size_t)cur.pn * tstepB;
    PG8_STAGE(PG8_SB(0, 0), cB, voffB); PG8_STAGE(PG8_SB(0, 1), cB + hstepB, voffB); PG8_STAGE(PG8_SA(0, 0), cA, voffA); PG8_STAGE(PG8_SA(0, 1), cA + hstepA, voffA);
    if (wr == 1) PG8_BAR;
    PG8_WAIT_V(2); PG8_BAR;
    PG8_STAGE(PG8_SB(1, 0), cB + kstep, voffB); PG8_STAGE(PG8_SA(1, 0), cA + kstep, voffA); PG8_STAGE(PG8_SB(1, 1), cB + hstepB + kstep, voffB);
    PG8_WAIT_V(6); PG8_BAR;
    for (;;) {
        const bool has_next = S.next(ui + 1, nxt);
        const char* nA = has_next ? (const char*)g.A + (size_t)nxt.pm * tstepA + (size_t)nxt.pn * g.a_pn_bytes : cA; const char* nB = has_next ? (const char*)g.Bt + (size_t)nxt.pn * tstepB : cB;
        for (int t = 0; t < nt; t += 2) {
            const bool last = (t == nt - 2);
            const char* a1 = cA + (size_t)(t + 1) * kstep;
            const char* a2 = last ? nA : cA + (size_t)(t + 2) * kstep; const char* b2 = last ? nB : cB + (size_t)(t + 2) * kstep;
            const char* a3 = a2 + kstep; const char* b3 = b2 + kstep;
            if constexpr (Epi::PREF) { if (last) E.pre(sv, cur, wr, fr); }
            PG8_LDB(B0, 0, 0); PG8_LDB(B1, 0, 1); PG8_SCHED; PG8_LDA(At, 0, 0); PG8_STAGE(PG8_SA(1, 1), a1 + hstepA, voffA);
            if (Epi::PREF && last) { PG8_WAIT_V(16); } else { PG8_WAIT_V(8); } PG8_WAIT_L(0); PG8_BAR; PG8_MMA(0, 0, At, B0); PG8_MMA(0, 1, At, B1); PG8_BAR; PG8_SCHED;
            PG8_LDA(At, 0, 1); PG8_STAGE(PG8_SB(0, 0), b2, voffB); PG8_STAGE(PG8_SB(0, 1), b2 + hstepB, voffB); PG8_STAGE(PG8_SA(0, 0), a2, voffA);
            if (Epi::PREF && last) { PG8_WAIT_V(16); } else { PG8_WAIT_V(8); } PG8_WAIT_L(0); PG8_BAR; PG8_MMA(1, 0, At, B0); PG8_MMA(1, 1, At, B1); PG8_BAR; PG8_SCHED;
            PG8_LDB(B0, 1, 0); PG8_LDB(B1, 1, 1); PG8_SCHED; PG8_LDA(At, 1, 0); PG8_STAGE(PG8_SA(0, 1), a2 + hstepA, voffA);
            PG8_WAIT_V(8); PG8_WAIT_L(0); PG8_BAR; PG8_MMA(0, 0, At, B0); PG8_MMA(0, 1, At, B1); PG8_BAR; PG8_SCHED;
            PG8_LDA(At, 1, 1); PG8_STAGE(PG8_SB(1, 0), b3, voffB); PG8_STAGE(PG8_SB(1, 1), b3 + hstepB, voffB); PG8_STAGE(PG8_SA(1, 0), a3, voffA);
            PG8_WAIT_V(8); PG8_WAIT_L(0); PG8_BAR; PG8_MMA(1, 0, At, B0); PG8_MMA(1, 1, At, B1); PG8_BAR; PG8_SCHED;
        }
        if constexpr (ALIGN_EPI) { if (wr == 0) PG8_BAR; }
        E(acc, cur, wr, wc, fr, fq, sv);
        if (!has_next) break;
#pragma unroll
        for (int a = 0; a < 2; ++a)
#pragma unroll
            for (int b = 0; b < 2; ++b)
#pragma unroll
                for (int m = 0; m < 4; ++m)
#pragma unroll
                    for (int n = 0; n < 2; ++n) acc[a][b][m][n] = (f32x4){0.f, 0.f, 0.f, 0.f};
        cur = nxt; cA = nA; cB = nB; ++ui;
        if constexpr (ALIGN_EPI) { if (wr == 1) PG8_BAR; }
    }
    PG8_WAIT_V(0);
    if constexpr (!ALIGN_EPI) { if (wr == 0) PG8_BAR; }
    PG8_BAR;
#undef PG8_SA
#undef PG8_SB
#undef PG8_STAGE
#undef PG8_LDA
#undef PG8_LDB
#undef PG8_MMA
#undef PG8_WAIT_V
#undef PG8_WAIT_L
#undef PG8_BAR
#undef PG8_SCHED
}
}

constexpr int TR_SCR = 64 * 65 * 4;
__device__ __forceinline__ void transpose_item(const float* W, int Nsrc, const float* gain, bf16_t* WT, int ldt, int k0, int n0, int drow0, LAS float* scr, int lane) {
    f32x4 v[16];
    const int lr = lane >> 4, lc = (lane & 15) * 4;
#pragma unroll
    for (int i = 0; i < 16; ++i) v[i] = *(const f32x4*)(W + (size_t)(k0 + 4 * i + lr) * Nsrc + n0 + lc);
#pragma unroll
    for (int i = 0; i < 16; ++i) { const int row = 4 * i + lr; const float g = gain ? gain[k0 + row] : 1.0f; LAS float* d = scr + row * 65 + lc;
        d[0] = v[i][0] * g; d[1] = v[i][1] * g; d[2] = v[i][2] * g; d[3] = v[i][3] * g; }
    LDS_WAIT(); asm volatile("" ::: "memory");
    const int c = lane & 7;
#pragma unroll
    for (int j = 0; j < 8; ++j) { const int n = (lane >> 3) + 8 * j; const LAS float* p = scr + (8 * c) * 65 + n;
        u32x4 o; o.x = cvt_pk_bf16(p[0 * 65], p[1 * 65]); o.y = cvt_pk_bf16(p[2 * 65], p[3 * 65]); o.z = cvt_pk_bf16(p[4 * 65], p[5 * 65]); o.w = cvt_pk_bf16(p[6 * 65], p[7 * 65]);
        *(u32x4*)(WT + (size_t)(drow0 + n) * ldt + k0 + 8 * c) = o; }
    LDS_WAIT(); asm volatile("" ::: "memory");
}
__device__ __forceinline__ void convert_ffn(const float* wg, const float* wu, const float* wd, const float* gain, bf16_t* WGU, bf16_t* WD, LAS float* scr, int gw, int NGW, int lane) {
    constexpr int NB_G = FF / 64, I_G = (D / 64) * NB_G, NB_D = D / 64, I_D = (FF / 64) * NB_D;
    for (int it = gw; it < 2 * I_G + I_D; it += NGW) {
        int r = it;
        if (r < 2 * I_G) { const int half = r >= I_G ? 1 : 0; r -= half * I_G; const int kb = r / NB_G, nb = r % NB_G, n0 = nb * 64;
            transpose_item(half ? wu : wg, FF, gain, WGU, D, kb * 64, n0, (n0 >> 7) * 256 + half * 128 + (n0 & 127), scr, lane); }
        else { r -= 2 * I_G; const int kb = r / NB_D, nb = r % NB_D; transpose_item(wd, D, nullptr, WD, FF, kb * 64, nb * 64, nb * 64, scr, lane); }
    }
}


#define XB_TMO      128
#define XB_XCNT(j)  (256  + 64 * (j))
#define XB_XSUB(j)  (1280 + 64 * (j))
#define XB_XGEN(j)  (2304 + 64 * (j))
#define XB_TOP      3328
#define XB_TOPGEN   3392
#define XCD_BAR_WORDS 3456
#define XB_SPIN_CAP (1u << 18)
__device__ __forceinline__ unsigned xb_ld(unsigned* p)              { return __hip_atomic_load(p, __ATOMIC_RELAXED, __HIP_MEMORY_SCOPE_AGENT); }
__device__ __forceinline__ unsigned xb_add(unsigned* p, unsigned v) { return __hip_atomic_fetch_add(p, v, __ATOMIC_RELAXED, __HIP_MEMORY_SCOPE_AGENT); }
__device__ __forceinline__ unsigned xb_xcc_id() { return (unsigned)__builtin_amdgcn_s_getreg((3 << 11) | 20) & 0xFu; }
#define XB_SPIN(cond, bar) do { unsigned _sp = 0; while (cond) { __builtin_amdgcn_s_sleep(1); \
    if ((++_sp & 255u) == 0u) { if (xb_ld(&(bar)[XB_TMO])) break; if (_sp > XB_SPIN_CAP) { atomicAdd(&(bar)[XB_TMO], 1u); break; } } } } while (0)
struct XcdBarrier { unsigned* bar; unsigned x; volatile LAS unsigned* st; };
__device__ __forceinline__ XcdBarrier xcd_barrier_post(unsigned* bar, volatile LAS unsigned* st) {
    XcdBarrier b; b.bar = bar; b.x = xb_xcc_id(); b.st = st;
    if (threadIdx.x == 0) (void)xb_add(&bar[XB_XCNT(b.x)], 1u);
    return b;
}
__device__ __forceinline__ void xcd_barrier_complete(unsigned* bar, unsigned x, unsigned& nloc, unsigned& nx) {
    const unsigned G = gridDim.x * gridDim.y * gridDim.z;
    unsigned sum, cnt, mine, sp = 0u;
    for (;;) {
        sum = 0u; cnt = 0u; mine = 0u;
#pragma unroll
        for (unsigned j = 0; j < 16; ++j) { const unsigned c = xb_ld(&bar[XB_XCNT(j)]); sum += c; cnt += (c > 0u) ? 1u : 0u; mine = (j == x) ? c : mine; }
        if (sum == G) break;
        __builtin_amdgcn_s_sleep(1);
        if ((++sp & 255u) == 0u) { if (xb_ld(&bar[XB_TMO])) break; if (sp > XB_SPIN_CAP) { atomicAdd(&bar[XB_TMO], 1u); break; } }
    }
    nloc = mine > 0u ? mine : 1u; nx = cnt > 0u ? cnt : 1u;
}
__device__ __forceinline__ void xcd_barrier(const XcdBarrier& b) {
    asm volatile("s_waitcnt vmcnt(0)" ::: "memory");
    __syncthreads();
    if (threadIdx.x == 0) {
        unsigned* bar = b.bar;
        __builtin_amdgcn_s_waitcnt(0);
        unsigned nloc = b.st[0], nx = b.st[1];
        if (nloc == 0u) { xcd_barrier_complete(bar, b.x, nloc, nx); b.st[0] = nloc; b.st[1] = nx; }
        const unsigned old = xb_add(&bar[XB_XSUB(b.x)], 1u);
        const unsigned gen = old / nloc;
        if (old + 1u == (gen + 1u) * nloc) {
            __builtin_amdgcn_fence(__ATOMIC_RELEASE, "agent");
            asm volatile("s_waitcnt vmcnt(0)" ::: "memory");
            const unsigned og = xb_add(&bar[XB_TOP], 1u);
            const unsigned tg = og / nx;
            if (og + 1u == (tg + 1u) * nx) xb_add(&bar[XB_TOPGEN], 1u);
            else XB_SPIN(xb_ld(&bar[XB_TOPGEN]) == tg, bar);
            __builtin_amdgcn_fence(__ATOMIC_ACQUIRE, "agent");
            xb_add(&bar[XB_XGEN(b.x)], 1u);
            asm volatile("s_waitcnt vmcnt(0)" ::: "memory");
        } else {
            XB_SPIN(xb_ld(&bar[XB_XGEN(b.x)]) == gen, bar);
            __builtin_amdgcn_fence(__ATOMIC_ACQUIRE, "agent");
            asm volatile("s_waitcnt vmcnt(0)" ::: "memory");
        }
    }
    __syncthreads();
}

struct Args { const float* in[23]; float* out; unsigned char* ws; };

__global__ void __launch_bounds__(512, 2) mega_fwd(Args args) {
    extern __shared__ __attribute__((aligned(16))) unsigned char lds_raw[];
    LAS unsigned char* lds = (LAS unsigned char*)lds_raw;
    cg::grid_group grid = cg::this_grid();
    const int G = gridDim.x, NGW = G * 8, NGT = G * 512;
    volatile LAS unsigned* bst = (volatile LAS unsigned*)(lds + LDS_BYTES - 16);
    if (threadIdx.x < 4) bst[threadIdx.x] = 0u;
    __syncthreads();
    if (args.ws == nullptr) grid.sync();
    const XcdBarrier xbar = xcd_barrier_post((unsigned*)(args.ws + WS_BAR), bst);
    unsigned char* ws = args.ws;
    const float* x = args.in[0]; float* out = args.out;
    float* ss0 = (float*)(ws + WS_SS); float* ss1 = ss0 + M; float* ss2 = ss1 + M; float* ss3 = ss2 + M;
    float* AT = (float*)(ws + WS_AT); float* HE = (float*)(ws + WS_HE); float* SP = (float*)(ws + WS_SP);
    bf16_t* WGU = (bf16_t*)(ws + WS_WGU); bf16_t* WD = (bf16_t*)(ws + WS_WD); bf16_t* WIN = (bf16_t*)(ws + WS_WIN); bf16_t* WOUT = (bf16_t*)(ws + WS_WOUT); bf16_t* WG = (bf16_t*)(ws + WS_WG);
    bf16_t* XB = (bf16_t*)(ws + WS_XB); bf16_t* LA = (bf16_t*)(ws + WS_LA); bf16_t* UU = (bf16_t*)(ws + WS_U); bf16_t* XC = (bf16_t*)(ws + WS_XC);
    bf16_t* Y = (bf16_t*)(ws + WS_Y); bf16_t* HB = (bf16_t*)(ws + WS_HZ); bf16_t* Z = (bf16_t*)(ws + WS_HZ);

    for (int rep = 0, nrep = opaque_s(REP_[0]); rep < nrep; ++rep) { PHASE_IDS;
    {
        {
            constexpr int NB_G = FF / 64, I_G = (D / 64) * NB_G, NB_D = D / 64, I_D = (FF / 64) * NB_D, NB_IN = DIN / 64, I_IN = (D / 64) * NB_IN, NB_O = D / 64, I_OUT = (D / 64) * NB_O;
            constexpr int T0 = 2 * I_G, T1 = T0 + I_D, T2 = T1 + I_IN, T3 = T2 + I_OUT, T4 = T3 + 64;
            for (int it = gw; it < T4; it += NGW) {
                if (it < T0) { int r = it; const int half = r >= I_G ? 1 : 0; r -= half * I_G; const int kb = r / NB_G, nb = r % NB_G, n0 = nb * 64;
                    transpose_item(half ? args.in[3] : args.in[2], FF, args.in[1], WGU, D, kb * 64, n0, (n0 >> 7) * 256 + half * 128 + (n0 & 127), scr, lane); }
                else if (it < T1) { const int r = it - T0, kb = r / NB_D, nb = r % NB_D; transpose_item(args.in[4], D, nullptr, WD, FF, kb * 64, nb * 64, nb * 64, scr, lane); }
                else if (it < T2) { const int r = it - T1, kb = r / NB_IN, nb = r % NB_IN;
                    const int n0 = nb * 64, q = n0 < 4 * DL ? n0 - 3 * DL : n0 - 4 * DL;
                    const int drow0 = n0 < 3 * DL ? n0 : 3 * DL + (q >> 7) * 256 + (n0 < 4 * DL ? 0 : 128) + (q & 127);
                    transpose_item(args.in[6], DIN, args.in[5], WIN, D, kb * 64, n0, drow0, scr, lane); }
                else if (it < T3) { const int r = it - T2, kb = r / NB_O, nb = r % NB_O; transpose_item(args.in[17], D, nullptr, WOUT, D, kb * 64, nb * 64, nb * 64, scr, lane); }
                else { const int r = it - T3, mat = r >> 5, h = (r >> 2) & 7, kb = (r >> 1) & 1, nb = r & 1;
                    transpose_item((mat ? args.in[11] : args.in[9]) + (size_t)h * 128 * 128, 128, nullptr, WG, GATE_K, kb * 64, nb * 64, h * 256 + mat * 128 + nb * 64, scr, lane); }
            }
        }
        if (GATE_K > 128) for (int i = gt; i < 2048 * 16; i += NGT) { const int row = i >> 4, c = i & 15; *(u32x4*)(WG + (size_t)row * GATE_K + 128 + c * 8) = (u32x4){0u, 0u, 0u, 0u}; }
        for (int i = gt; i < 3 * M; i += NGT) ss1[i] = 0.f;
        for (int i = gt; i < DL; i += NGT) SP[i] = -8.0f * 1.4426950408889634f * log1pf(expf(-args.in[13][i]));
        for (int m = gw; m < M; m += 2 * NGW) {
            const int m2 = (m + NGW < M) ? m + NGW : m;
            const f32x4* xr = (const f32x4*)(x + (size_t)m * D) + lane; const f32x4* xr2 = (const f32x4*)(x + (size_t)m2 * D) + lane;
            f32x4 va[8], vb[8];
#pragma unroll
            for (int j = 0; j < 8; ++j) { va[j] = xr[64 * j]; vb[j] = xr2[64 * j]; }
            u32x2* o8 = (u32x2*)(XB + (size_t)m * D) + lane; u32x2* o82 = (u32x2*)(XB + (size_t)m2 * D) + lane; float s = 0.f, s2 = 0.f;
#pragma unroll
            for (int j = 0; j < 8; ++j) { const f32x4 v = va[j], w2 = vb[j];
                s += (v[0] * v[0] + v[1] * v[1]) + (v[2] * v[2] + v[3] * v[3]); s2 += (w2[0] * w2[0] + w2[1] * w2[1]) + (w2[2] * w2[2] + w2[3] * w2[3]);
                u32x2 w; w.x = cvt_pk_bf16(v[0], v[1]); w.y = cvt_pk_bf16(v[2], v[3]); o8[64 * j] = w;
                u32x2 w3; w3.x = cvt_pk_bf16(w2[0], w2[1]); w3.y = cvt_pk_bf16(w2[2], w2[3]); o82[64 * j] = w3; }
#pragma unroll
            for (int o = 1; o < 64; o <<= 1) { s += __shfl_xor(s, o); s2 += __shfl_xor(s2, o); }
            if (lane == 0) { ss0[m] = s; ss0[m2] = s2; }
        }
    }
    xcd_barrier(xbar); }
    for (int rep = 0, nrep = opaque_s(REP_[1]); rep < nrep; ++rep) {
    { pg8::Gemm g{XB, WGU, M, 2 * FF, D, D, D, 0}; pg8::StaticOrder S; S.init(M, 2 * FF, G, (int)blockIdx.x); pg8::EpiSwiglu E{HB, ss0};
      pg8::gemm_phase<pg8::EpiSwiglu, EPI_ALIGN>(lds, g, S, E); }
    xcd_barrier(xbar); }
    for (int rep = 0, nrep = opaque_s(REP_[2]); rep < nrep; ++rep) {
    { pg8::Gemm g{HB, WD, M, D, FF, FF, FF, 0}; pg8::StaticOrder S; S.init(M, D, G, (int)blockIdx.x); pg8::EpiResid E{nullptr, XB, XB, ss1, 0.5f};
      pg8::gemm_phase<pg8::EpiResid, EPI_ALIGN>(lds, g, S, E); }
    xcd_barrier(xbar); }
    for (int rep = 0, nrep = opaque_s(REP_[3]); rep < nrep; ++rep) {
    { pg8::Gemm g{XB, WIN, M, DIN, D, D, D, 0}; pg8::StaticOrder S; S.init(M, DIN, G, (int)blockIdx.x); pg8::EpiZ E{Z, ss1};
      pg8::gemm_phase<pg8::EpiZ, EPI_ALIGN>(lds, g, S, E); }
    xcd_barrier(xbar); }
    for (int rep = 0, nrep = opaque_s(REP_[4]); rep < nrep; ++rep) { PHASE_IDS;
    {
        convert_ffn(args.in[19], args.in[20], args.in[21], args.in[18], WGU, WD, scr, gw, NGW, lane);
    }
    __syncthreads(); }
    for (int rep = 0, nrep = opaque_s(REP_[5]); rep < nrep; ++rep) {
    { pg8::Gemm g{XC, WG, M, 2048, GATE_K, DL, GATE_K, 256}; pg8::StaticOrder S; S.init(M, 2048, G, (int)blockIdx.x);
      pg8::EpiGates E{XC, LA, UU, args.in[10], args.in[12], SP, AT, HE};
      const int nu = (S.nwg + G - 1) / G;
      _Pragma("nounroll") for (int part = 0; part < nu; ++part) {
          pg8::Unit u; S.lo = 0; S.hi = 0x7fffffff; if (!S.next(part, u)) break;
          { int tidv = threadIdx.x; asm volatile("" : "+v"(tidv));
            const float* cw = args.in[7]; const float* cb = args.in[8];
            const int c0 = u.pn * 128 + (tidv & 15) * 8, r0 = u.pm * 256 + (tidv >> 4) * 8, t0 = r0 & (SEQ - 1);
            u32x4 zr[11];
#pragma unroll
            for (int r = 0; r < 11; ++r) zr[r] = (t0 + r - 3 >= 0) ? *(const u32x4*)(Z + (size_t)(r0 + r - 3) * DIN + c0) : (u32x4){0u, 0u, 0u, 0u};
            float wk[4][8], bs[8];
#pragma unroll
            for (int k = 0; k < 4; ++k) { const f32x4 w0 = *(const f32x4*)(cw + k * DL + c0), w1 = *(const f32x4*)(cw + k * DL + c0 + 4);
                wk[k][0] = w0[0]; wk[k][1] = w0[1]; wk[k][2] = w0[2]; wk[k][3] = w0[3]; wk[k][4] = w1[0]; wk[k][5] = w1[1]; wk[k][6] = w1[2]; wk[k][7] = w1[3]; }
#pragma unroll
            for (int e = 0; e < 8; ++e) bs[e] = cb[c0 + e];
#pragma unroll
            for (int r = 0; r < 8; ++r) {
                float acc[8];
#pragma unroll
                for (int e = 0; e < 8; ++e) acc[e] = bs[e];
#pragma unroll
                for (int k = 0; k < 4; ++k) { const u32x4 v = zr[r + k];
                    acc[0] += wk[k][0] * bf_lo(v.x); acc[1] += wk[k][1] * bf_hi(v.x); acc[2] += wk[k][2] * bf_lo(v.y); acc[3] += wk[k][3] * bf_hi(v.y);
                    acc[4] += wk[k][4] * bf_lo(v.z); acc[5] += wk[k][5] * bf_hi(v.z); acc[6] += wk[k][6] * bf_lo(v.w); acc[7] += wk[k][7] * bf_hi(v.w); }
                u32x4 w; w.x = cvt_pk_bf16(acc[0], acc[1]); w.y = cvt_pk_bf16(acc[2], acc[3]); w.z = cvt_pk_bf16(acc[4], acc[5]); w.w = cvt_pk_bf16(acc[6], acc[7]);
                *(u32x4*)(XC + (size_t)(r0 + r) * DL + c0) = w;
            }
          }
      }
      asm volatile("s_waitcnt vmcnt(0)" ::: "memory");
      __syncthreads();
      S.lo = 0; S.hi = 0x7fffffff;
      pg8::gemm_phase<pg8::EpiGates, EPI_ALIGN, true>(lds, g, S, E); }
    xcd_barrier(xbar); }
    for (int rep = 0, nrep = opaque_s(REP_[7]); rep < nrep; ++rep) { PHASE_IDS;
    for (int unit = blockIdx.x; unit < NCHUNK; unit += G) {
        int tidv = tid; asm volatile("" : "+v"(tidv));
        const int cidx = unit & (CPB - 1), m0 = unit * CHUNK, ch = 2 * tidv;
        LAS float* cst = (LAS float*)(lds + P7_CST_OFF);
        f32x2 cv[5];
        cv[0] = *(const f32x2*)(args.in[15] + ch); cv[1] = *(const f32x2*)(args.in[16] + ch);
#pragma unroll
        for (int k = 0; k < 3; ++k) cv[2 + k] = *(const f32x2*)(args.in[14] + k * DL + ch);
        f32x2 h = (f32x2){0.f, 0.f};
        { const f32x2* at = (const f32x2*)(AT + (size_t)(unit - cidx) * DL + ch); const f32x2* he = (const f32x2*)(HE + (size_t)(unit - cidx) * DL + ch);
#pragma unroll 16
          for (int c = 0; c < cidx; ++c) { const f32x2 a = at[(size_t)c * (DL / 2)], e = he[(size_t)c * (DL / 2)]; h = a * h + e; } }
#pragma unroll
        for (int k = 0; k < 5; ++k) *(LAS f32x2*)(cst + k * DL + ch) = cv[k];
        LAS unsigned* yt = (LAS unsigned*)lds;
        unsigned la_[2][16], u_[2][16], g_[2][16];
#pragma unroll
        for (int q = 0; q < 16; ++q) { const size_t m = (size_t)(m0 + q);
            la_[0][q] = *(const unsigned*)(LA + m * DL + ch); u_[0][q] = *(const unsigned*)(UU + m * DL + ch); g_[0][q] = *(const unsigned*)(Z + m * DIN + DL + ch); }
#pragma unroll
        for (int tb = 0; tb < 4; ++tb) {
            if (tb < 3) {
#pragma unroll
                for (int q = 0; q < 16; ++q) { const size_t m = (size_t)(m0 + (tb + 1) * 16 + q);
                    la_[(tb + 1) & 1][q] = *(const unsigned*)(LA + m * DL + ch); u_[(tb + 1) & 1][q] = *(const unsigned*)(UU + m * DL + ch); g_[(tb + 1) & 1][q] = *(const unsigned*)(Z + m * DIN + DL + ch); }
            }
#pragma unroll
            for (int q = 0; q < 16; ++q) {
                const unsigned lw = la_[tb & 1][q], uw = u_[tb & 1][q], gw2 = g_[tb & 1][q];
                h[0] = __builtin_amdgcn_exp2f(bf_lo(lw)) * h[0] + bf_lo(uw); h[1] = __builtin_amdgcn_exp2f(bf_hi(lw)) * h[1] + bf_hi(uw);
                yt[(tb * 16 + q) * 512 + tidv] = cvt_pk_bf16(h[0] * bf_lo(gw2), h[1] * bf_hi(gw2));
            }
        }
        __syncthreads();
        {
            float cx1[2][8], cx2[2][8];
            const int tw0 = m0 + wave * 8;
            int lanev = tidv & 63; asm volatile("" : "+v"(lanev));
#pragma unroll
            for (int j = 0; j < 2; ++j) {
                const int c = 8 * lanev + 512 * j;
#pragma unroll
                for (int p = 1; p <= 2; ++p) {
                    float* dst = (p == 1) ? cx1[j] : cx2[j];
                    if (((tw0 & (SEQ - 1)) - p) >= 0) {
                        const u32x4 cvv = *(const u32x4*)(Z + (size_t)(tw0 - p) * DIN + 3 * DL + c);
                        dst[0] = bf_lo(cvv.x); dst[1] = bf_hi(cvv.x); dst[2] = bf_lo(cvv.y); dst[3] = bf_hi(cvv.y); dst[4] = bf_lo(cvv.z); dst[5] = bf_hi(cvv.z); dst[6] = bf_lo(cvv.w); dst[7] = bf_hi(cvv.w);
                    } else {
#pragma unroll
                        for (int e = 0; e < 8; ++e) dst[e] = 0.f;
                    }
                }
            }
#pragma unroll
            for (int tb = 0; tb < 8; tb += 4) {
                u32x4 zb[4][2], zc[4][2];
#pragma unroll
                for (int q = 0; q < 4; ++q)
#pragma unroll
                    for (int j = 0; j < 2; ++j) { const size_t mq = (size_t)(m0 + wave * 8 + tb + q); const int c = 8 * lanev + 512 * j;
                        zb[q][j] = *(const u32x4*)(Z + mq * DIN + 2 * DL + c); zc[q][j] = *(const u32x4*)(Z + mq * DIN + 3 * DL + c); }
#pragma unroll
                for (int qp = 0; qp < 4; ++qp) {
                    float yl[1][2][8], ys[1][2][8], sl[1] = {0.f}, s2[1] = {0.f};
#pragma unroll
                    for (int qq = 0; qq < 1; ++qq) {
                        const int q = qp + qq, t = wave * 8 + tb + q;
#pragma unroll
                        for (int j = 0; j < 2; ++j) {
                            const int c = 8 * lanev + 512 * j;
                            const u32x4 v = *(const LAS u32x4*)(lds + t * 2048 + c * 2);
                            yl[qq][j][0] = bf_lo(v.x); yl[qq][j][1] = bf_hi(v.x); yl[qq][j][2] = bf_lo(v.y); yl[qq][j][3] = bf_hi(v.y); yl[qq][j][4] = bf_lo(v.z); yl[qq][j][5] = bf_hi(v.z); yl[qq][j][6] = bf_lo(v.w); yl[qq][j][7] = bf_hi(v.w);
#pragma unroll
                            for (int e = 0; e < 8; ++e) sl[qq] += yl[qq][j][e] * yl[qq][j][e];
                            const u32x4 bv = zb[q][j], cvv = zc[q][j];
                            float cx0[8], bb[8], w0[8], w1[8], w2[8];
                            cx0[0] = bf_lo(cvv.x); cx0[1] = bf_hi(cvv.x); cx0[2] = bf_lo(cvv.y); cx0[3] = bf_hi(cvv.y); cx0[4] = bf_lo(cvv.z); cx0[5] = bf_hi(cvv.z); cx0[6] = bf_lo(cvv.w); cx0[7] = bf_hi(cvv.w);
                            bb[0] = bf_lo(bv.x); bb[1] = bf_hi(bv.x); bb[2] = bf_lo(bv.y); bb[3] = bf_hi(bv.y); bb[4] = bf_lo(bv.z); bb[5] = bf_hi(bv.z); bb[6] = bf_lo(bv.w); bb[7] = bf_hi(bv.w);
                            { const f32x4 a0 = *(const LAS f32x4*)(cst + 2 * DL + c), a1 = *(const LAS f32x4*)(cst + 2 * DL + c + 4), b0 = *(const LAS f32x4*)(cst + 3 * DL + c), b1 = *(const LAS f32x4*)(cst + 3 * DL + c + 4), c0 = *(const LAS f32x4*)(cst + 4 * DL + c), c1 = *(const LAS f32x4*)(cst + 4 * DL + c + 4);
#pragma unroll
                              for (int e = 0; e < 4; ++e) { w0[e] = a0[e]; w0[4 + e] = a1[e]; w1[e] = b0[e]; w1[4 + e] = b1[e]; w2[e] = c0[e]; w2[4 + e] = c1[e]; } }
#pragma unroll
                            for (int e = 0; e < 8; ++e) {
                                const float vv = bb[e] * (w0[e] * cx2[j][e] + w1[e] * cx1[j][e] + w2[e] * cx0[e]);
                                ys[qq][j][e] = vv; s2[qq] += vv * vv; cx2[j][e] = cx1[j][e]; cx1[j][e] = cx0[e];
                            }
                        }
                    }
#pragma unroll
                    for (int o = 1; o < 64; o <<= 1) { sl[0] += __shfl_xor(sl[0], o); s2[0] += __shfl_xor(s2[0], o); }
#pragma unroll
                    for (int qq = 0; qq < 1; ++qq) {
                        const size_t m = (size_t)(m0 + wave * 8 + tb + qp + qq);
                        const float rl = __builtin_amdgcn_rsqf(sl[qq] * (1.0f / DL) + EPS), rs = __builtin_amdgcn_rsqf(s2[qq] * (1.0f / DL) + EPS);
#pragma unroll
                        for (int j = 0; j < 2; ++j) {
                            const int c = 8 * lanev + 512 * j;
                            const f32x4 g0 = *(const LAS f32x4*)(cst + c), g1 = *(const LAS f32x4*)(cst + c + 4), k0 = *(const LAS f32x4*)(cst + DL + c), k1 = *(const LAS f32x4*)(cst + DL + c + 4);
                            u32x4 w; w.x = cvt_pk_bf16(yl[qq][j][0] * rl * g0[0], yl[qq][j][1] * rl * g0[1]); w.y = cvt_pk_bf16(yl[qq][j][2] * rl * g0[2], yl[qq][j][3] * rl * g0[3]);
                            w.z = cvt_pk_bf16(yl[qq][j][4] * rl * g1[0], yl[qq][j][5] * rl * g1[1]); w.w = cvt_pk_bf16(yl[qq][j][6] * rl * g1[2], yl[qq][j][7] * rl * g1[3]);
                            *(u32x4*)(Y + m * D + c) = w;
                            u32x4 w3; w3.x = cvt_pk_bf16(ys[qq][j][0] * rs * k0[0], ys[qq][j][1] * rs * k0[1]); w3.y = cvt_pk_bf16(ys[qq][j][2] * rs * k0[2], ys[qq][j][3] * rs * k0[3]);
                            w3.z = cvt_pk_bf16(ys[qq][j][4] * rs * k1[0], ys[qq][j][5] * rs * k1[1]); w3.w = cvt_pk_bf16(ys[qq][j][6] * rs * k1[2], ys[qq][j][7] * rs * k1[3]);
                            *(u32x4*)(Y + m * D + DL + c) = w3;
                        }
                    }
                }
            }
        }
        __syncthreads();
    }
    xcd_barrier(xbar); }
    for (int rep = 0, nrep = opaque_s(REP_[8]); rep < nrep; ++rep) {
    { pg8::Gemm g{Y, WOUT, M, D, D, D, D, 0}; pg8::StaticOrder S; S.init(M, D, G, (int)blockIdx.x); pg8::EpiResid E{nullptr, XB, XB, ss2, 1.0f};
      pg8::gemm_phase<pg8::EpiResid, EPI_ALIGN>(lds, g, S, E); }
    xcd_barrier(xbar); }
    for (int rep = 0, nrep = opaque_s(REP_[9]); rep < nrep; ++rep) {
    { pg8::Gemm g{XB, WGU, M, 2 * FF, D, D, D, 0}; pg8::StaticOrder S; S.init(M, 2 * FF, G, (int)blockIdx.x); pg8::EpiSwiglu E{HB, ss2};
      pg8::gemm_phase<pg8::EpiSwiglu, EPI_ALIGN>(lds, g, S, E); }
    xcd_barrier(xbar); }
    for (int rep = 0, nrep = opaque_s(REP_[10]); rep < nrep; ++rep) {
    { pg8::Gemm g{HB, WD, M, D, FF, FF, FF, 0}; pg8::StaticOrder S; S.init(M, D, G, (int)blockIdx.x); pg8::EpiResid E{nullptr, XB, XB, ss3, 0.5f};
      pg8::gemm_phase<pg8::EpiResid, EPI_ALIGN>(lds, g, S, E); }
    xcd_barrier(xbar); }
    {
        PHASE_IDS; const float* fg = args.in[22];
        for (int m0 = gw; m0 < M; m0 += 2 * NGW) {
            u32x4 v[2][4]; float r[2];
#pragma unroll
            for (int p = 0; p < 2; ++p) { const int m = (m0 + p * NGW < M) ? m0 + p * NGW : m0; r[p] = __builtin_amdgcn_rsqf(ss3[m] * (1.0f / D) + EPS); const u32x4* xi = (const u32x4*)(XB + (size_t)m * D) + lane;
#pragma unroll
                for (int j = 0; j < 4; ++j) v[p][j] = xi[64 * j]; }
#pragma unroll
            for (int p = 0; p < 2; ++p) { const int m = (m0 + p * NGW < M) ? m0 + p * NGW : m0; f32x4* o = (f32x4*)(out + (size_t)m * D) + 2 * lane; const f32x4* gg = (const f32x4*)fg + 2 * lane; const float rr = r[p];
#pragma unroll
                for (int j = 0; j < 4; ++j) { const f32x4 g0 = gg[128 * j], g1 = gg[128 * j + 1]; const u32x4 q = v[p][j];
                    __builtin_nontemporal_store((f32x4){bf_lo(q.x) * rr * g0[0], bf_hi(q.x) * rr * g0[1], bf_lo(q.y) * rr * g0[2], bf_hi(q.y) * rr * g0[3]}, o + 128 * j);
                    __builtin_nontemporal_store((f32x4){bf_lo(q.z) * rr * g1[0], bf_hi(q.z) * rr * g1[1], bf_lo(q.w) * rr * g1[2], bf_hi(q.w) * rr * g1[3]}, o + 128 * j + 1); } }
        }
    }
}

extern "C" void kernel_launch(void* const* d_in, const int* in_sizes, int n_in, void* d_out, int out_size, void* d_ws, size_t ws_size, hipStream_t stream) {
    static int grid = 0;
    if (grid == 0) {
        if (n_in != 23 || in_sizes[0] != M * D || out_size != M * D || ws_size < WS_END) { fprintf(stderr, "kernel_launch: unexpected shapes (n_in %d in0 %d out %d ws %zu)\n", n_in, n_in > 0 ? in_sizes[0] : -1, out_size, ws_size); grid = -1; return; }
        int dev = 0, cus = 0, per_cu = 0;
        (void)hipGetDevice(&dev); (void)hipDeviceGetAttribute(&cus, hipDeviceAttributeMultiprocessorCount, dev);
        (void)hipFuncSetAttribute((const void*)mega_fwd, hipFuncAttributeMaxDynamicSharedMemorySize, LDS_BYTES);
        if (hipOccupancyMaxActiveBlocksPerMultiprocessor(&per_cu, (const void*)mega_fwd, 512, LDS_BYTES) != hipSuccess || per_cu < 1) per_cu = 1;
        (void)hipGetLastError();
        grid = cus * per_cu;
    }
    if (grid < 0) return;
    if (hipMemsetAsync((char*)d_ws + WS_BAR, 0, BAR_BYTES, stream) != hipSuccess) { fprintf(stderr, "kernel_launch: memset of barrier words failed\n"); return; }
    Args a{};
    for (int i = 0; i < 23; ++i) a.in[i] = (const float*)d_in[i];
    a.out = (float*)d_out; a.ws = (unsigned char*)d_ws;
    void* kargs[] = {&a};
    hipError_t e = hipLaunchCooperativeKernel((const void*)mega_fwd, dim3(grid), dim3(512), kargs, LDS_BYTES, stream);
    if (e != hipSuccess) fprintf(stderr, "cooperative launch failed: %s (grid %d)\n", hipGetErrorString(e), grid);
}
```

```cpp
#include <hip/hip_runtime.h>
#include <hip/hip_cooperative_groups.h>
#include <cstdio>
#include <cstdint>
namespace cg = cooperative_groups;

#define LAS __attribute__((address_space(3)))
#define GAS __attribute__((address_space(1)))
typedef unsigned short bf16_t;
typedef short bf16x8 __attribute__((ext_vector_type(8)));
typedef float f32x4 __attribute__((ext_vector_type(4)));
typedef float f32x2 __attribute__((ext_vector_type(2)));
typedef unsigned u32x4 __attribute__((ext_vector_type(4)));
typedef unsigned u32x2 __attribute__((ext_vector_type(2)));

constexpr int M = 16384, D = 2048, FF = 5632, DIN = 5120, DL = 1024, SEQ = 8192, CHUNK = 64, NCHUNK = M / CHUNK, CPB = SEQ / CHUNK;
constexpr float EPS = 1e-6f;
constexpr int GATE_K = 128;
constexpr size_t MiB = 1u << 20;
constexpr size_t WS_SS = 0;
constexpr size_t WS_AT = 1 * MiB, WS_HE = 2 * MiB;
constexpr size_t WS_BAR = 3 * MiB + 65536, BAR_BYTES = 16384;
constexpr size_t WS_SP = 3 * MiB;
constexpr size_t WS_WGU = 4 * MiB, WS_WD = 48 * MiB, WS_WIN = 70 * MiB, WS_WOUT = 90 * MiB, WS_WG = 98 * MiB;
constexpr size_t WS_XB = 100 * MiB;
constexpr size_t WS_U = 164 * MiB, WS_XC = 196 * MiB, WS_Y = 228 * MiB, WS_HZ = 292 * MiB, WS_LA = 468 * MiB, WS_END = 500 * MiB;
constexpr int P7_CST_OFF = 133120, LDS_BYTES = P7_CST_OFF + 5 * 1024 * 4 + 64;
constexpr bool EPI_ALIGN = true;
#define REPV {1, 1, 1, 1, 1, 1, 1, 1, 1, 1, 1, 1}
constexpr int REP_[12] = REPV;

__device__ __forceinline__ unsigned cvt_pk_bf16(float lo, float hi) { unsigned r; asm volatile("v_cvt_pk_bf16_f32 %0, %1, %2" : "=v"(r) : "v"(lo), "v"(hi)); return r; }
__device__ __forceinline__ float bf_lo(unsigned w) { return __uint_as_float(w << 16); }
__device__ __forceinline__ float bf_hi(unsigned w) { return __uint_as_float(w & 0xffff0000u); }
__device__ __forceinline__ float sigmoidf_(float x) { return __builtin_amdgcn_rcpf(1.0f + __expf(-x)); }
__device__ __forceinline__ float gelu_tanh(float x) {
    const float v = 0.7978845608028654f * (x + 0.044715f * x * x * x);
    const float e = __expf(2.0f * v);
    const float th = 1.0f - 2.0f * __builtin_amdgcn_rcpf(e + 1.0f);
    return 0.5f * x * (1.0f + th);
}
__device__ __forceinline__ float wave_sum(float v) {
#pragma unroll
    for (int o = 1; o < 64; o <<= 1) v += __shfl_xor(v, o);
    return v;
}
__device__ __forceinline__ int opaque_s(int v) { if (v != 1) asm volatile("" : "+s"(v)); return v; }
#define PHASE_IDS int tid = threadIdx.x; asm volatile("" : "+v"(tid)); const int lane = tid & 63, wave = __builtin_amdgcn_readfirstlane(tid >> 6), gw = blockIdx.x * 8 + wave, gt = blockIdx.x * 512 + tid; (void)lane; (void)gw; (void)gt; LAS float* scr = (LAS float*)(lds + wave * TR_SCR); (void)scr;
#define LDS_WAIT() asm volatile("s_waitcnt lgkmcnt(0)" ::: "memory")

namespace pg8 {
constexpr int BM = 256, BK = 64, HALF = 128, HTB = HALF * BK * 2, STAGE_BYTES = 8 * HTB, NXCD = 8, WGM = 4;
__host__ __device__ __forceinline__ int lds_byte(int r, int c) { const int st = (r >> 4) * 2 + (c >> 5), rr = r & 15, cc = c & 31, ob = rr * 64 + cc * 2; return st * 1024 + (ob ^ (((ob >> 9) & 1) << 5)); }
__host__ __device__ __forceinline__ void stage_rc(int b, int& R, int& C) { const int st = b / 1024, sb = b % 1024, swz = sb ^ (((sb >> 9) & 1) << 5); R = (st >> 1) * 16 + swz / 64; C = (st & 1) * 32 + (swz % 64) / 2; }
__host__ __device__ __forceinline__ int perm32(int rho) { const int n = rho >> 4, i = rho & 15; return 8 * (i >> 2) + 4 * n + (i & 3); }

struct Unit { int pm, pn; };
struct Gemm { const bf16_t* A; const bf16_t* Bt; int M, N, K, lda, ldb, a_pn_bytes; };

struct StaticOrder {
    int nM, nN, nwg, G, c, lo, hi;
    __host__ __device__ void init(int M_, int N_, int G_, int c_) { nM = M_ / BM; nN = N_ / BM; nwg = nM * nN; G = G_; c = c_; lo = 0; hi = 0x7fffffff; }
    __host__ __device__ bool next(int i, Unit& u) const {
        const long L = (long)i * G + c; if (i >= hi || L >= nwg) return false;
        int wgid = (int)L; { const int q = nwg / NXCD, r = nwg % NXCD, xcd = wgid % NXCD, off = wgid / NXCD; wgid = (xcd < r ? xcd * (q + 1) : r * (q + 1) + (xcd - r) * q) + off; }
        const int nig = WGM * nN, gid = wgid / nig, fm = gid * WGM, gsz = (nM - fm) < WGM ? (nM - fm) : WGM;
        u.pm = fm + ((wgid % nig) % gsz); u.pn = (wgid % nig) / gsz; return true;
    }
};


struct EpiSwiglu {
    static constexpr bool PREF = true;
    __device__ __forceinline__ void pre(float (&sv)[8], const Unit& u, int wr, int fr) const { const int row0 = u.pm * BM + wr * 64 + fr;
_Pragma("unroll") for (int i = 0; i < 8; ++i) sv[i] = ss[row0 + (i >> 2) * HALF + (i & 3) * 16]; }
    bf16_t* H; const float* ss;
    __device__ __forceinline__ void operator()(const f32x4 (&acc)[2][2][4][2], const Unit& u, int wr, int wc, int fr, int fq, const float (&sv)[8]) const {
        const int row0 = u.pm * BM + wr * 64 + fr, col0 = u.pn * 128 + wc * 32 + 8 * fq;
#pragma unroll
        for (int ai = 0; ai < 2; ++ai)
#pragma unroll
            for (int m = 0; m < 4; ++m) {
                const int row = row0 + ai * HALF + m * 16;
                const float var = sv[ai * 4 + m] * (1.0f / D) + EPS;
                const float c1 = -1.4426950408889634f * __builtin_amdgcn_rsqf(var);
                f32x2 hh[4];
#pragma unroll
                for (int p = 0; p < 4; ++p) {
                    const f32x2 g = (f32x2){acc[ai][0][m][p >> 1][(p & 1) * 2], acc[ai][0][m][p >> 1][(p & 1) * 2 + 1]};
                    const f32x2 up = (f32x2){acc[ai][1][m][p >> 1][(p & 1) * 2], acc[ai][1][m][p >> 1][(p & 1) * 2 + 1]};
                    const f32x2 t = g * c1; f32x2 d; d.x = __builtin_amdgcn_exp2f(t.x); d.y = __builtin_amdgcn_exp2f(t.y); d = d * var + var;
                    f32x2 r; r.x = __builtin_amdgcn_rcpf(d.x); r.y = __builtin_amdgcn_rcpf(d.y);
                    hh[p] = (g * up) * r;
                }
                u32x4 w; w.x = cvt_pk_bf16(hh[0].x, hh[0].y); w.y = cvt_pk_bf16(hh[1].x, hh[1].y); w.z = cvt_pk_bf16(hh[2].x, hh[2].y); w.w = cvt_pk_bf16(hh[3].x, hh[3].y);
                *(u32x4*)(H + (size_t)row * FF + col0) = w;
            }
    }
};
struct EpiResid {
    static constexpr bool PREF = false;
    const float* base; const bf16_t* bbase; bf16_t* xb; float* ss; float scale;
    __device__ __forceinline__ void operator()(const f32x4 (&acc)[2][2][4][2], const Unit& u, int wr, int wc, int fr, int fq, const float (&)[8]) const {
        const int row0 = u.pm * BM + wr * 64 + fr, col0 = u.pn * BM + wc * 32 + 8 * fq;
        u32x4 bw[2][2][2];
#define RES_LOAD(c, buf) _Pragma("unroll") for (int mi = 0; mi < 2; ++mi) _Pragma("unroll") for (int bj = 0; bj < 2; ++bj) \
            bw[buf][mi][bj] = *(const u32x4*)(bbase + (size_t)(row0 + ((c) >> 1) * HALF + (((c) & 1) * 2 + mi) * 16) * D + col0 + bj * HALF)
        RES_LOAD(0, 0);
#pragma unroll
        for (int c = 0; c < 4; ++c) {
            if (c < 3) { RES_LOAD(c + 1, (c + 1) & 1); }
            const int ai = c >> 1;
#pragma unroll
            for (int mi = 0; mi < 2; ++mi) {
                const int m = (c & 1) * 2 + mi, row = row0 + ai * HALF + m * 16; float s = 0.f;
#pragma unroll
                for (int bj = 0; bj < 2; ++bj) {
                    const size_t off = (size_t)row * D + col0 + bj * HALF; const u32x4 r = bw[c & 1][mi][bj];
                    const f32x4 o0 = (f32x4){bf_lo(r.x), bf_hi(r.x), bf_lo(r.y), bf_hi(r.y)} + acc[ai][bj][m][0] * scale, o1 = (f32x4){bf_lo(r.z), bf_hi(r.z), bf_lo(r.w), bf_hi(r.w)} + acc[ai][bj][m][1] * scale;
                    u32x4 w; w.x = cvt_pk_bf16(o0[0], o0[1]); w.y = cvt_pk_bf16(o0[2], o0[3]); w.z = cvt_pk_bf16(o1[0], o1[1]); w.w = cvt_pk_bf16(o1[2], o1[3]); *(u32x4*)(xb + off) = w;
                    s += (o0[0] * o0[0] + o0[1] * o0[1]) + (o0[2] * o0[2] + o0[3] * o0[3]) + (o1[0] * o1[0] + o1[1] * o1[1]) + (o1[2] * o1[2] + o1[3] * o1[3]);
                }
                s += __shfl_xor(s, 16); s += __shfl_xor(s, 32);
                if (fq == 0) atomicAdd(ss + row, s);
            }
        }
#undef RES_LOAD
    }
};
struct EpiZ {
    static constexpr bool PREF = true;
    __device__ __forceinline__ void pre(float (&sv)[8], const Unit& u, int wr, int fr) const { const int row0 = u.pm * BM + wr * 64 + fr;
_Pragma("unroll") for (int i = 0; i < 8; ++i) sv[i] = ss[row0 + (i >> 2) * HALF + (i & 3) * 16]; }
    bf16_t* Z; const float* ss;
    __device__ __forceinline__ void operator()(const f32x4 (&acc)[2][2][4][2], const Unit& u, int wr, int wc, int fr, int fq, const float (&sv)[8]) const {
        const int row0 = u.pm * BM + wr * 64 + fr, col0 = u.pn * BM + wc * 32 + 8 * fq;
        const bool prod = u.pn >= 12, gate = (u.pn >= 4 && u.pn < 8); const int colp = 3 * DL + (u.pn - 12) * 128 + wc * 32 + 8 * fq;
#pragma unroll
        for (int ai = 0; ai < 2; ++ai)
#pragma unroll
            for (int m = 0; m < 4; ++m) {
                const int row = row0 + ai * HALF + m * 16;
                const float rstd = __builtin_amdgcn_rsqf(sv[ai * 4 + m] * (1.0f / D) + EPS);
                if (prod) {
                    const float r2 = rstd * rstd;
                    const f32x4 v0 = acc[ai][0][m][0] * acc[ai][1][m][0] * r2, v1 = acc[ai][0][m][1] * acc[ai][1][m][1] * r2;
                    u32x4 w; w.x = cvt_pk_bf16(v0[0], v0[1]); w.y = cvt_pk_bf16(v0[2], v0[3]); w.z = cvt_pk_bf16(v1[0], v1[1]); w.w = cvt_pk_bf16(v1[2], v1[3]);
                    *(u32x4*)(Z + (size_t)row * DIN + colp) = w;
                } else {
#pragma unroll
                    for (int bj = 0; bj < 2; ++bj) {
                        f32x4 v0 = acc[ai][bj][m][0] * rstd, v1 = acc[ai][bj][m][1] * rstd;
                        if (gate) {
#pragma unroll
                            for (int e = 0; e < 4; ++e) { v0[e] = gelu_tanh(v0[e]); v1[e] = gelu_tanh(v1[e]); } }
                        u32x4 w; w.x = cvt_pk_bf16(v0[0], v0[1]); w.y = cvt_pk_bf16(v0[2], v0[3]); w.z = cvt_pk_bf16(v1[0], v1[1]); w.w = cvt_pk_bf16(v1[2], v1[3]);
                        *(u32x4*)(Z + (size_t)row * DIN + col0 + bj * HALF) = w;
                    }
                }
            }
    }
};
struct EpiGates {
    static constexpr bool PREF = false;
    const bf16_t* XC; bf16_t* LAout; bf16_t* Uout; const float* ba; const float* bi; const float* sp; float* AT; float* HE;
    __device__ __forceinline__ void operator()(const f32x4 (&acc)[2][2][4][2], const Unit& u, int wr, int wc, int fr, int fq, const float (&sv)[8]) const {
        const int rowb = u.pm * BM + wr * 64, ch0 = u.pn * 128 + wc * 32 + 8 * fq;
        float vba[8], vbi[8], sp8[8];
#pragma unroll
        for (int e = 0; e < 8; ++e) { vba[e] = ba[ch0 + e]; vbi[e] = bi[ch0 + e]; sp8[e] = sp[ch0 + e]; }
        u32x4 xws[8];
#pragma unroll
        for (int i = 0; i < 8; ++i) xws[i] = *(const u32x4*)(XC + (size_t)(rowb + (i >> 2) * HALF + 4 * fr + (i & 3)) * DL + ch0);
#pragma unroll
        for (int ai = 0; ai < 2; ++ai) {
            float Pc[8], Hc[8];
#pragma unroll
            for (int m = 0; m < 4; ++m) {
                const int row = rowb + ai * HALF + 4 * fr + m; const size_t off = (size_t)row * DL + ch0;
                const u32x4 xw = xws[ai * 4 + m];
                float xc[8] = {bf_lo(xw.x), bf_hi(xw.x), bf_lo(xw.y), bf_hi(xw.y), bf_lo(xw.z), bf_hi(xw.z), bf_lo(xw.w), bf_hi(xw.w)};
                float av[8], uv[8];
#pragma unroll
                for (int e = 0; e < 8; ++e) {
                    const float r = sigmoidf_(acc[ai][0][m][e >> 2][e & 3] + vba[e]), ig = sigmoidf_(acc[ai][1][m][e >> 2][e & 3] + vbi[e]);
                    av[e] = r * sp8[e];
                    uv[e] = ig * xc[e];
                }
                u32x4 wa; wa.x = cvt_pk_bf16(av[0], av[1]); wa.y = cvt_pk_bf16(av[2], av[3]); wa.z = cvt_pk_bf16(av[4], av[5]); wa.w = cvt_pk_bf16(av[6], av[7]); *(u32x4*)(LAout + off) = wa;
                const float ar[8] = {bf_lo(wa.x), bf_hi(wa.x), bf_lo(wa.y), bf_hi(wa.y), bf_lo(wa.z), bf_hi(wa.z), bf_lo(wa.w), bf_hi(wa.w)};
                float aa[8];
#pragma unroll
                for (int e = 0; e < 8; ++e) {
                    aa[e] = __builtin_amdgcn_exp2f(ar[e]);
                    uv[e] *= __builtin_amdgcn_sqrtf(fmaxf(1.0f - aa[e] * aa[e], 0.f));
                }
                u32x4 w; w.x = cvt_pk_bf16(uv[0], uv[1]); w.y = cvt_pk_bf16(uv[2], uv[3]); w.z = cvt_pk_bf16(uv[4], uv[5]); w.w = cvt_pk_bf16(uv[6], uv[7]);
                *(u32x4*)(Uout + off) = w;
                const float ur[8] = {bf_lo(w.x), bf_hi(w.x), bf_lo(w.y), bf_hi(w.y), bf_lo(w.z), bf_hi(w.z), bf_lo(w.w), bf_hi(w.w)};
#pragma unroll
                for (int e = 0; e < 8; ++e) { const float a = aa[e];
                    if (m == 0) { Pc[e] = a; Hc[e] = ur[e]; } else { Hc[e] = a * Hc[e] + ur[e]; Pc[e] *= a; } }
            }
#pragma unroll
            for (int sft = 1; sft < 16; sft <<= 1)
#pragma unroll
                for (int e = 0; e < 8; ++e) { const float Pn = __shfl_down(Pc[e], sft, 16), Hn = __shfl_down(Hc[e], sft, 16); Hc[e] = Pn * Hc[e] + Hn; Pc[e] *= Pn; }
            if (fr == 0) { const size_t so = (size_t)((rowb + ai * HALF) >> 6) * DL + ch0;
                *(f32x4*)(AT + so) = (f32x4){Pc[0], Pc[1], Pc[2], Pc[3]}; *(f32x4*)(AT + so + 4) = (f32x4){Pc[4], Pc[5], Pc[6], Pc[7]};
                *(f32x4*)(HE + so) = (f32x4){Hc[0], Hc[1], Hc[2], Hc[3]}; *(f32x4*)(HE + so + 4) = (f32x4){Hc[4], Hc[5], Hc[6], Hc[7]}; }
        }
    }
};

template <class Epi, bool ALIGN_EPI, bool APERM = false>
__device__ __forceinline__ void gemm_phase(LAS unsigned char* lds, const Gemm g, const StaticOrder& S, const Epi& E) {
    int tid_ = threadIdx.x; asm volatile("" : "+v"(tid_));
    const int tid = tid_, wid = __builtin_amdgcn_readfirstlane(tid >> 6), lane = tid & 63, wr = wid >> 2, wc = wid & 3, fr = lane & 15, fq = lane >> 4;
    int K_ = g.K; asm volatile("" : "+s"(K_));
    const int K = K_, nt = K / BK;
    unsigned voffA[2], voffB[2];
#pragma unroll
    for (int i = 0; i < 2; ++i) { int R, C; stage_rc(tid * 16 + i * 8192, R, C); const int Rb = (R & ~31) + perm32(R & 31);
        const int Ra = APERM ? ((R & ~63) + 4 * (R & 15) + ((R & 63) >> 4)) : R;
        voffA[i] = (unsigned)(Ra * g.lda + C) * 2u; voffB[i] = (unsigned)(Rb * g.ldb + C) * 2u; }
    const size_t kstep = (size_t)(BK * 2);
    const size_t hstepA = (size_t)HALF * g.lda * 2, hstepB = (size_t)HALF * g.ldb * 2;
    const size_t tstepA = 2 * hstepA, tstepB = 2 * hstepB;
    const unsigned ldsw = (unsigned)wid * 1024u;
    const int aoff = lds_byte(wr * 64 + fr, fq * 8), boff = lds_byte(wc * 32 + fr, fq * 8);
#define PG8_SA(b, h) (((b) * 2 + (h)) * HTB)
#define PG8_SB(b, h) ((4 + (b) * 2 + (h)) * HTB)
#define PG8_STAGE(bufoff, gbase, voff) do { _Pragma("unroll") for (int _i = 0; _i < 2; ++_i) \
        __builtin_amdgcn_global_load_lds((const unsigned*)((const char*)(gbase) + (voff)[_i]), (LAS unsigned*)(lds + (bufoff) + ldsw + _i * 8192), 16, 0, 0); } while (0)
#define PG8_LDA(dst, b, h) do { _Pragma("unroll") for (int m = 0; m < 4; ++m) _Pragma("unroll") for (int k = 0; k < 2; ++k) dst[m][k] = *(const LAS bf16x8*)(lds + PG8_SA(b, h) + aoff + m * 2048 + k * 1024); } while (0)
#define PG8_LDB(dst, b, h) do { _Pragma("unroll") for (int n = 0; n < 2; ++n) _Pragma("unroll") for (int k = 0; k < 2; ++k) dst[n][k] = *(const LAS bf16x8*)(lds + PG8_SB(b, h) + boff + n * 2048 + k * 1024); } while (0)
#define PG8_MMA(ai, bj, At, Bt) do { __builtin_amdgcn_s_setprio(1); _Pragma("unroll") for (int m = 0; m < 4; ++m) _Pragma("unroll") for (int n = 0; n < 2; ++n) _Pragma("unroll") for (int k = 0; k < 2; ++k) \
        acc[ai][bj][m][n] = __builtin_amdgcn_mfma_f32_16x16x32_bf16(Bt[n][k], At[m][k], acc[ai][bj][m][n], 0, 0, 0); __builtin_amdgcn_s_setprio(0); } while (0)
#define PG8_WAIT_V(n) asm volatile("s_waitcnt vmcnt(" #n ")" ::: "memory")
#define PG8_WAIT_L(n) asm volatile("s_waitcnt lgkmcnt(" #n ")" ::: "memory")
#define PG8_BAR __builtin_amdgcn_s_barrier()
#define PG8_SCHED __builtin_amdgcn_sched_barrier(0)
    Unit cur, nxt; int ui = S.lo;
    if (!S.next(ui, cur)) return;
    f32x4 acc[2][2][4][2];
#pragma unroll
    for (int a = 0; a < 2; ++a)
#pragma unroll
        for (int b = 0; b < 2; ++b)
#pragma unroll
            for (int m = 0; m < 4; ++m)
#pragma unroll
                for (int n = 0; n < 2; ++n) acc[a][b][m][n] = (f32x4){0.f, 0.f, 0.f, 0.f};
    bf16x8 At[4][2], B0[2][2], B1[2][2];
    float sv[8] = {0.f, 0.f, 0.f, 0.f, 0.f, 0.f, 0.f, 0.f};
    const char* cA = (const char*)g.A + (size_t)cur.pm * tstepA + (size_t)cur.pn * g.a_pn_bytes; const char* cB = (const char*)g.Bt + (size_t)cur.pn * tstepB;
    PG8_STAGE(PG8_SB(0, 0), cB, voffB); PG8_STAGE(PG8_SB(0, 1), cB + hstepB, voffB); PG8_STAGE(PG8_SA(0, 0), cA, voffA); PG8_STAGE(PG8_SA(0, 1), cA + hstepA, voffA);
    if (wr == 1) PG8_BAR;
    PG8_WAIT_V(2); PG8_BAR;
    PG8_STAGE(PG8_SB(1, 0), cB + kstep, voffB); PG8_STAGE(PG8_SA(1, 0), cA + kstep, voffA); PG8_STAGE(PG8_SB(1, 1), cB + hstepB + kstep, voffB);
    PG8_WAIT_V(6); PG8_BAR;
    for (;;) {
        const bool has_next = S.next(ui + 1, nxt);
        const char* nA = has_next ? (const char*)g.A + (size_t)nxt.pm * tstepA + (size_t)nxt.pn * g.a_pn_bytes : cA; const char* nB = has_next ? (const char*)g.Bt + (size_t)nxt.pn * tstepB : cB;
        for (int t = 0; t < nt; t += 2) {
            const bool last = (t == nt - 2);
            const char* a1 = cA + (size_t)(t + 1) * kstep;
            const char* a2 = last ? nA : cA + (size_t)(t + 2) * kstep; const char* b2 = last ? nB : cB + (size_t)(t + 2) * kstep;
            const char* a3 = a2 + kstep; const char* b3 = b2 + kstep;
            if constexpr (Epi::PREF) { if (last) E.pre(sv, cur, wr, fr); }
            PG8_LDB(B0, 0, 0); PG8_LDB(B1, 0, 1); PG8_SCHED; PG8_LDA(At, 0, 0); PG8_STAGE(PG8_SA(1, 1), a1 + hstepA, voffA);
            if (Epi::PREF && last) { PG8_WAIT_V(16); } else { PG8_WAIT_V(8); } PG8_WAIT_L(0); PG8_BAR; PG8_MMA(0, 0, At, B0); PG8_MMA(0, 1, At, B1); PG8_BAR; PG8_SCHED;
            PG8_LDA(At, 0, 1); PG8_STAGE(PG8_SB(0, 0), b2, voffB); PG8_STAGE(PG8_SB(0, 1), b2 + hstepB, voffB); PG8_STAGE(PG8_SA(0, 0), a2, voffA);
            if (Epi::PREF && last) { PG8_WAIT_V(16); } else { PG8_WAIT_V(8); } PG8_WAIT_L(0); PG8_BAR; PG8_MMA(1, 0, At, B0); PG8_MMA(1, 1, At, B1); PG8_BAR; PG8_SCHED;
            PG8_LDB(B0, 1, 0); PG8_LDB(B1, 1, 1); PG8_SCHED; PG8_LDA(At, 1, 0); PG8_STAGE(PG8_SA(0, 1), a2 + hstepA, voffA);
            PG8_WAIT_V(8); PG8_WAIT_L(0); PG8_BAR; PG8_MMA(0, 0, At, B0); PG8_MMA(0, 1, At, B1); PG8_BAR; PG8_SCHED;
            PG8_LDA(At, 1, 1); PG8_STAGE(PG8_SB(1, 0), b3, voffB); PG8_STAGE(PG8_SB(1, 1), b3 + hstepB, voffB); PG8_STAGE(PG8_SA(1, 0), a3, voffA);
            PG8_WAIT_V(8); PG8_WAIT_L(0); PG8_BAR; PG8_MMA(1, 0, At, B0); PG8_MMA(1, 1, At, B1); PG8_BAR; PG8_SCHED;
        }
        if constexpr (ALIGN_EPI) { if (wr == 0) PG8_BAR; }
        E(acc, cur, wr, wc, fr, fq, sv);
        if (!has_next) break;
#pragma unroll
        for (int a = 0; a < 2; ++a)
#pragma unroll
            for (int b = 0; b < 2; ++b)
#pragma unroll
                for (int m = 0; m < 4; ++m)
#pragma unroll
                    for (int n = 0; n < 2; ++n) acc[a][b][m][n] = (f32x4){0.f, 0.f, 0.f, 0.f};
        cur = nxt; cA = nA; cB = nB; ++ui;
        if constexpr (ALIGN_EPI) { if (wr == 1) PG8_BAR; }
    }
    PG8_WAIT_V(0);
    if constexpr (!ALIGN_EPI) { if (wr == 0) PG8_BAR; }
    PG8_BAR;
#undef PG8_SA
#undef PG8_SB
#undef PG8_STAGE
#undef PG8_LDA
#undef PG8_LDB
#undef PG8_MMA
#undef PG8_WAIT_V
#undef PG8_WAIT_L
#undef PG8_BAR
#undef PG8_SCHED
}
}

constexpr int TR_SCR = 64 * 65 * 4;
__device__ __forceinline__ void transpose_item(const float* W, int Nsrc, const float* gain, bf16_t* WT, int ldt, int k0, int n0, int drow0, LAS float* scr, int lane) {
    f32x4 v[16];
    const int lr = lane >> 4, lc = (lane & 15) * 4;
#pragma unroll
    for (int i = 0; i < 16; ++i) v[i] = *(const f32x4*)(W + (size_t)(k0 + 4 * i + lr) * Nsrc + n0 + lc);
#pragma unroll
    for (int i = 0; i < 16; ++i) { const int row = 4 * i + lr; const float g = gain ? gain[k0 + row] : 1.0f; LAS float* d = scr + row * 65 + lc;
        d[0] = v[i][0] * g; d[1] = v[i][1] * g; d[2] = v[i][2] * g; d[3] = v[i][3] * g; }
    LDS_WAIT(); asm volatile("" ::: "memory");
    const int c = lane & 7;
#pragma unroll
    for (int j = 0; j < 8; ++j) { const int n = (lane >> 3) + 8 * j; const LAS float* p = scr + (8 * c) * 65 + n;
        u32x4 o; o.x = cvt_pk_bf16(p[0 * 65], p[1 * 65]); o.y = cvt_pk_bf16(p[2 * 65], p[3 * 65]); o.z = cvt_pk_bf16(p[4 * 65], p[5 * 65]); o.w = cvt_pk_bf16(p[6 * 65], p[7 * 65]);
        *(u32x4*)(WT + (size_t)(drow0 + n) * ldt + k0 + 8 * c) = o; }
    LDS_WAIT(); asm volatile("" ::: "memory");
}
__device__ __forceinline__ void convert_ffn(const float* wg, const float* wu, const float* wd, const float* gain, bf16_t* WGU, bf16_t* WD, LAS float* scr, int gw, int NGW, int lane) {
    constexpr int NB_G = FF / 64, I_G = (D / 64) * NB_G, NB_D = D / 64, I_D = (FF / 64) * NB_D;
    for (int it = gw; it < 2 * I_G + I_D; it += NGW) {
        int r = it;
        if (r < 2 * I_G) { const int half = r >= I_G ? 1 : 0; r -= half * I_G; const int kb = r / NB_G, nb = r % NB_G, n0 = nb * 64;
            transpose_item(half ? wu : wg, FF, gain, WGU, D, kb * 64, n0, (n0 >> 7) * 256 + half * 128 + (n0 & 127), scr, lane); }
        else { r -= 2 * I_G; const int kb = r / NB_D, nb = r % NB_D; transpose_item(wd, D, nullptr, WD, FF, kb * 64, nb * 64, nb * 64, scr, lane); }
    }
}


#define XB_TMO      128
#define XB_XCNT(j)  (256  + 64 * (j))
#define XB_XSUB(j)  (1280 + 64 * (j))
#define XB_XGEN(j)  (2304 + 64 * (j))
#define XB_TOP      3328
#define XB_TOPGEN   3392
#define XCD_BAR_WORDS 3456
#define XB_SPIN_CAP (1u << 18)
__device__ __forceinline__ unsigned xb_ld(unsigned* p)              { return __hip_atomic_load(p, __ATOMIC_RELAXED, __HIP_MEMORY_SCOPE_AGENT); }
__device__ __forceinline__ unsigned xb_add(unsigned* p, unsigned v) { return __hip_atomic_fetch_add(p, v, __ATOMIC_RELAXED, __HIP_MEMORY_SCOPE_AGENT); }
__device__ __forceinline__ unsigned xb_xcc_id() { return (unsigned)__builtin_amdgcn_s_getreg((3 << 11) | 20) & 0xFu; }
#define XB_SPIN(cond, bar) do { unsigned _sp = 0; while (cond) { __builtin_amdgcn_s_sleep(1); \
    if ((++_sp & 255u) == 0u) { if (xb_ld(&(bar)[XB_TMO])) break; if (_sp > XB_SPIN_CAP) { atomicAdd(&(bar)[XB_TMO], 1u); break; } } } } while (0)
struct XcdBarrier { unsigned* bar; unsigned x; volatile LAS unsigned* st; };
__device__ __forceinline__ XcdBarrier xcd_barrier_post(unsigned* bar, volatile LAS unsigned* st) {
    XcdBarrier b; b.bar = bar; b.x = xb_xcc_id(); b.st = st;
    if (threadIdx.x == 0) (void)xb_add(&bar[XB_XCNT(b.x)], 1u);
    return b;
}
__device__ __forceinline__ void xcd_barrier_complete(unsigned* bar, unsigned x, unsigned& nloc, unsigned& nx) {
    const unsigned G = gridDim.x * gridDim.y * gridDim.z;
    unsigned sum, cnt, mine, sp = 0u;
    for (;;) {
        sum = 0u; cnt = 0u; mine = 0u;
#pragma unroll
        for (unsigned j = 0; j < 16; ++j) { const unsigned c = xb_ld(&bar[XB_XCNT(j)]); sum += c; cnt += (c > 0u) ? 1u : 0u; mine = (j == x) ? c : mine; }
        if (sum == G) break;
        __builtin_amdgcn_s_sleep(1);
        if ((++sp & 255u) == 0u) { if (xb_ld(&bar[XB_TMO])) break; if (sp > XB_SPIN_CAP) { atomicAdd(&bar[XB_TMO], 1u); break; } }
    }
    nloc = mine > 0u ? mine : 1u; nx = cnt > 0u ? cnt : 1u;
}
__device__ __forceinline__ void xcd_barrier(const XcdBarrier& b) {
    asm volatile("s_waitcnt vmcnt(0)" ::: "memory");
    __syncthreads();
    if (threadIdx.x == 0) {
        unsigned* bar = b.bar;
        __builtin_amdgcn_s_waitcnt(0);
        unsigned nloc = b.st[0], nx = b.st[1];
        if (nloc == 0u) { xcd_barrier_complete(bar, b.x, nloc, nx); b.st[0] = nloc; b.st[1] = nx; }
        const unsigned old = xb_add(&bar[XB_XSUB(b.x)], 1u);
        const unsigned gen = old / nloc;
        if (old + 1u == (gen + 1u) * nloc) {
            __builtin_amdgcn_fence(__ATOMIC_RELEASE, "agent");
            asm volatile("s_waitcnt vmcnt(0)" ::: "memory");
            const unsigned og = xb_add(&bar[XB_TOP], 1u);
            const unsigned tg = og / nx;
            if (og + 1u == (tg + 1u) * nx) xb_add(&bar[XB_TOPGEN], 1u);
            else XB_SPIN(xb_ld(&bar[XB_TOPGEN]) == tg, bar);
            __builtin_amdgcn_fence(__ATOMIC_ACQUIRE, "agent");
            xb_add(&bar[XB_XGEN(b.x)], 1u);
            asm volatile("s_waitcnt vmcnt(0)" ::: "memory");
        } else {
            XB_SPIN(xb_ld(&bar[XB_XGEN(b.x)]) == gen, bar);
            __builtin_amdgcn_fence(__ATOMIC_ACQUIRE, "agent");
            asm volatile("s_waitcnt vmcnt(0)" ::: "memory");
        }
    }
    __syncthreads();
}

struct Args { const float* in[23]; float* out; unsigned char* ws; };

__global__ void __launch_bounds__(512, 2) mega_fwd(Args args) {
    extern __shared__ __attribute__((aligned(16))) unsigned char lds_raw[];
    LAS unsigned char* lds = (LAS unsigned char*)lds_raw;
    cg::grid_group grid = cg::this_grid();
    const int G = gridDim.x, NGW = G * 8, NGT = G * 512;
    volatile LAS unsigned* bst = (volatile LAS unsigned*)(lds + LDS_BYTES - 16);
    if (threadIdx.x < 4) bst[threadIdx.x] = 0u;
    __syncthreads();
    if (args.ws == nullptr) grid.sync();
    const XcdBarrier xbar = xcd_barrier_post((unsigned*)(args.ws + WS_BAR), bst);
    unsigned char* ws = args.ws;
    const float* x = args.in[0]; float* out = args.out;
    float* ss0 = (float*)(ws + WS_SS); float* ss1 = ss0 + M; float* ss2 = ss1 + M; float* ss3 = ss2 + M;
    float* AT = (float*)(ws + WS_AT); float* HE = (float*)(ws + WS_HE); float* SP = (float*)(ws + WS_SP);
    bf16_t* WGU = (bf16_t*)(ws + WS_WGU); bf16_t* WD = (bf16_t*)(ws + WS_WD); bf16_t* WIN = (bf16_t*)(ws + WS_WIN); bf16_t* WOUT = (bf16_t*)(ws + WS_WOUT); bf16_t* WG = (bf16_t*)(ws + WS_WG);
    bf16_t* XB = (bf16_t*)(ws + WS_XB); bf16_t* LA = (bf16_t*)(ws + WS_LA); bf16_t* UU = (bf16_t*)(ws + WS_U); bf16_t* XC = (bf16_t*)(ws + WS_XC);
    bf16_t* Y = (bf16_t*)(ws + WS_Y); bf16_t* HB = (bf16_t*)(ws + WS_HZ); bf16_t* Z = (bf16_t*)(ws + WS_HZ);

    for (int rep = 0, nrep = opaque_s(REP_[0]); rep < nrep; ++rep) { PHASE_IDS;
    {
        {
            constexpr int NB_G = FF / 64, I_G = (D / 64) * NB_G, NB_D = D / 64, I_D = (FF / 64) * NB_D, NB_IN = DIN / 64, I_IN = (D / 64) * NB_IN, NB_O = D / 64, I_OUT = (D / 64) * NB_O;
            constexpr int T0 = 2 * I_G, T1 = T0 + I_D, T2 = T1 + I_IN, T3 = T2 + I_OUT, T4 = T3 + 64;
            for (int it = gw; it < T4; it += NGW) {
                if (it < T0) { int r = it; const int half = r >= I_G ? 1 : 0; r -= half * I_G; const int kb = r / NB_G, nb = r % NB_G, n0 = nb * 64;
                    transpose_item(half ? args.in[3] : args.in[2], FF, args.in[1], WGU, D, kb * 64, n0, (n0 >> 7) * 256 + half * 128 + (n0 & 127), scr, lane); }
                else if (it < T1) { const int r = it - T0, kb = r / NB_D, nb = r % NB_D; transpose_item(args.in[4], D, nullptr, WD, FF, kb * 64, nb * 64, nb * 64, scr, lane); }
                else if (it < T2) { const int r = it - T1, kb = r / NB_IN, nb = r % NB_IN;
                    const int n0 = nb * 64, q = n0 < 4 * DL ? n0 - 3 * DL : n0 - 4 * DL;
                    const int drow0 = n0 < 3 * DL ? n0 : 3 * DL + (q >> 7) * 256 + (n0 < 4 * DL ? 0 : 128) + (q & 127);
                    transpose_item(args.in[6], DIN, args.in[5], WIN, D, kb * 64, n0, drow0, scr, lane); }
                else if (it < T3) { const int r = it - T2, kb = r / NB_O, nb = r % NB_O; transpose_item(args.in[17], D, nullptr, WOUT, D, kb * 64, nb * 64, nb * 64, scr, lane); }
                else { const int r = it - T3, mat = r >> 5, h = (r >> 2) & 7, kb = (r >> 1) & 1, nb = r & 1;
                    transpose_item((mat ? args.in[11] : args.in[9]) + (size_t)h * 128 * 128, 128, nullptr, WG, GATE_K, kb * 64, nb * 64, h * 256 + mat * 128 + nb * 64, scr, lane); }
            }
        }
        if (GATE_K > 128) for (int i = gt; i < 2048 * 16; i += NGT) { const int row = i >> 4, c = i & 15; *(u32x4*)(WG + (size_t)row * GATE_K + 128 + c * 8) = (u32x4){0u, 0u, 0u, 0u}; }
        for (int i = gt; i < 3 * M; i += NGT) ss1[i] = 0.f;
        for (int i = gt; i < DL; i += NGT) SP[i] = -8.0f * 1.4426950408889634f * log1pf(expf(-args.in[13][i]));
        for (int m = gw; m < M; m += 2 * NGW) {
            const int m2 = (m + NGW < M) ? m + NGW : m;
            const f32x4* xr = (const f32x4*)(x + (size_t)m * D) + lane; const f32x4* xr2 = (const f32x4*)(x + (size_t)m2 * D) + lane;
            f32x4 va[8], vb[8];
#pragma unroll
            for (int j = 0; j < 8; ++j) { va[j] = xr[64 * j]; vb[j] = xr2[64 * j]; }
            u32x2* o8 = (u32x2*)(XB + (size_t)m * D) + lane; u32x2* o82 = (u32x2*)(XB + (size_t)m2 * D) + lane; float s = 0.f, s2 = 0.f;
#pragma unroll
            for (int j = 0; j < 8; ++j) { const f32x4 v = va[j], w2 = vb[j];
                s += (v[0] * v[0] + v[1] * v[1]) + (v[2] * v[2] + v[3] * v[3]); s2 += (w2[0] * w2[0] + w2[1] * w2[1]) + (w2[2] * w2[2] + w2[3] * w2[3]);
                u32x2 w; w.x = cvt_pk_bf16(v[0], v[1]); w.y = cvt_pk_bf16(v[2], v[3]); o8[64 * j] = w;
                u32x2 w3; w3.x = cvt_pk_bf16(w2[0], w2[1]); w3.y = cvt_pk_bf16(w2[2], w2[3]); o82[64 * j] = w3; }
#pragma unroll
            for (int o = 1; o < 64; o <<= 1) { s += __shfl_xor(s, o); s2 += __shfl_xor(s2, o); }
            if (lane == 0) { ss0[m] = s; ss0[m2] = s2; }
        }
    }
    xcd_barrier(xbar); }
    for (int rep = 0, nrep = opaque_s(REP_[1]); rep < nrep; ++rep) {
    { pg8::Gemm g{XB, WGU, M, 2 * FF, D, D, D, 0}; pg8::StaticOrder S; S.init(M, 2 * FF, G, (int)blockIdx.x); pg8::EpiSwiglu E{HB, ss0};
      pg8::gemm_phase<pg8::EpiSwiglu, EPI_ALIGN>(lds, g, S, E); }
    xcd_barrier(xbar); }
    for (int rep = 0, nrep = opaque_s(REP_[2]); rep < nrep; ++rep) {
    { pg8::Gemm g{HB, WD, M, D, FF, FF, FF, 0}; pg8::StaticOrder S; S.init(M, D, G, (int)blockIdx.x); pg8::EpiResid E{nullptr, XB, XB, ss1, 0.5f};
      pg8::gemm_phase<pg8::EpiResid, EPI_ALIGN>(lds, g, S, E); }
    xcd_barrier(xbar); }
    for (int rep = 0, nrep = opaque_s(REP_[3]); rep < nrep; ++rep) {
    { pg8::Gemm g{XB, WIN, M, DIN, D, D, D, 0}; pg8::StaticOrder S; S.init(M, DIN, G, (int)blockIdx.x); pg8::EpiZ E{Z, ss1};
      pg8::gemm_phase<pg8::EpiZ, EPI_ALIGN>(lds, g, S, E); }
    xcd_barrier(xbar); }
    for (int rep = 0, nrep = opaque_s(REP_[4]); rep < nrep; ++rep) { PHASE_IDS;
    {
        convert_ffn(args.in[19], args.in[20], args.in[21], args.in[18], WGU, WD, scr, gw, NGW, lane);
    }
    __syncthreads(); }
    for (int rep = 0, nrep = opaque_s(REP_[5]); rep < nrep; ++rep) {
    { pg8::Gemm g{XC, WG, M, 2048, GATE_K, DL, GATE_K, 256}; pg8::StaticOrder S; S.init(M, 2048, G, (int)blockIdx.x);
      pg8::EpiGates E{XC, LA, UU, args.in[10], args.in[12], SP, AT, HE};
      const int nu = (S.nwg + G - 1) / G;
      _Pragma("unroll 2") for (int part = 0; part < nu; ++part) {
          pg8::Unit u; S.lo = 0; S.hi = 0x7fffffff; if (!S.next(part, u)) break;
          { int tidv = threadIdx.x; asm volatile("" : "+v"(tidv));
            const float* cw = args.in[7]; const float* cb = args.in[8];
            const int c0 = u.pn * 128 + (tidv & 15) * 8, r0 = u.pm * 256 + (tidv >> 4) * 8, t0 = r0 & (SEQ - 1);
            u32x4 zr[11];
#pragma unroll
            for (int r = 0; r < 11; ++r) zr[r] = (t0 + r - 3 >= 0) ? *(const u32x4*)(Z + (size_t)(r0 + r - 3) * DIN + c0) : (u32x4){0u, 0u, 0u, 0u};
            float wk[4][8], bs[8];
#pragma unroll
            for (int k = 0; k < 4; ++k) { const f32x4 w0 = *(const f32x4*)(cw + k * DL + c0), w1 = *(const f32x4*)(cw + k * DL + c0 + 4);
                wk[k][0] = w0[0]; wk[k][1] = w0[1]; wk[k][2] = w0[2]; wk[k][3] = w0[3]; wk[k][4] = w1[0]; wk[k][5] = w1[1]; wk[k][6] = w1[2]; wk[k][7] = w1[3]; }
#pragma unroll
            for (int e = 0; e < 8; ++e) bs[e] = cb[c0 + e];
#pragma unroll
            for (int r = 0; r < 8; ++r) {
                float acc[8];
#pragma unroll
                for (int e = 0; e < 8; ++e) acc[e] = bs[e];
#pragma unroll
                for (int k = 0; k < 4; ++k) { const u32x4 v = zr[r + k];
                    acc[0] += wk[k][0] * bf_lo(v.x); acc[1] += wk[k][1] * bf_hi(v.x); acc[2] += wk[k][2] * bf_lo(v.y); acc[3] += wk[k][3] * bf_hi(v.y);
                    acc[4] += wk[k][4] * bf_lo(v.z); acc[5] += wk[k][5] * bf_hi(v.z); acc[6] += wk[k][6] * bf_lo(v.w); acc[7] += wk[k][7] * bf_hi(v.w); }
                u32x4 w; w.x = cvt_pk_bf16(acc[0], acc[1]); w.y = cvt_pk_bf16(acc[2], acc[3]); w.z = cvt_pk_bf16(acc[4], acc[5]); w.w = cvt_pk_bf16(acc[6], acc[7]);
                *(u32x4*)(XC + (size_t)(r0 + r) * DL + c0) = w;
            }
          }
      }
      asm volatile("s_waitcnt vmcnt(0)" ::: "memory");
      __syncthreads();
      S.lo = 0; S.hi = 0x7fffffff;
      pg8::gemm_phase<pg8::EpiGates, EPI_ALIGN, true>(lds, g, S, E); }
    xcd_barrier(xbar); }
    for (int rep = 0, nrep = opaque_s(REP_[7]); rep < nrep; ++rep) { PHASE_IDS;
    for (int unit = blockIdx.x; unit < NCHUNK; unit += G) {
        int tidv = tid; asm volatile("" : "+v"(tidv));
        const int cidx = unit & (CPB - 1), m0 = unit * CHUNK, ch = 2 * tidv;
        LAS float* cst = (LAS float*)(lds + P7_CST_OFF);
        f32x2 cv[5];
        cv[0] = *(const f32x2*)(args.in[15] + ch); cv[1] = *(const f32x2*)(args.in[16] + ch);
#pragma unroll
        for (int k = 0; k < 3; ++k) cv[2 + k] = *(const f32x2*)(args.in[14] + k * DL + ch);
        unsigned la_[2][16], u_[2][16], g_[2][16];
#pragma unroll
        for (int q = 0; q < 16; ++q) { const size_t m = (size_t)(m0 + q);
            la_[0][q] = *(const unsigned*)(LA + m * DL + ch); u_[0][q] = *(const unsigned*)(UU + m * DL + ch); g_[0][q] = *(const unsigned*)(Z + m * DIN + DL + ch); }
        f32x2 h = (f32x2){0.f, 0.f};
        { const f32x2* at = (const f32x2*)(AT + (size_t)(unit - cidx) * DL + ch); const f32x2* he = (const f32x2*)(HE + (size_t)(unit - cidx) * DL + ch);
#pragma unroll 32
          for (int c = 0; c < cidx; ++c) { const f32x2 a = at[(size_t)c * (DL / 2)], e = he[(size_t)c * (DL / 2)]; h = a * h + e; } }
#pragma unroll
        for (int k = 0; k < 5; ++k) *(LAS f32x2*)(cst + k * DL + ch) = cv[k];
        LAS unsigned* yt = (LAS unsigned*)lds;
#pragma unroll
        for (int tb = 0; tb < 4; ++tb) {
            if (tb < 3) {
#pragma unroll
                for (int q = 0; q < 16; ++q) { const size_t m = (size_t)(m0 + (tb + 1) * 16 + q);
                    la_[(tb + 1) & 1][q] = *(const unsigned*)(LA + m * DL + ch); u_[(tb + 1) & 1][q] = *(const unsigned*)(UU + m * DL + ch); g_[(tb + 1) & 1][q] = *(const unsigned*)(Z + m * DIN + DL + ch); }
            }
#pragma unroll
            for (int q = 0; q < 16; ++q) {
                const unsigned lw = la_[tb & 1][q], uw = u_[tb & 1][q], gw2 = g_[tb & 1][q];
                h[0] = __builtin_amdgcn_exp2f(bf_lo(lw)) * h[0] + bf_lo(uw); h[1] = __builtin_amdgcn_exp2f(bf_hi(lw)) * h[1] + bf_hi(uw);
                yt[(tb * 16 + q) * 512 + tidv] = cvt_pk_bf16(h[0] * bf_lo(gw2), h[1] * bf_hi(gw2));
            }
        }
        __syncthreads();
        {
            float cx1[2][8], cx2[2][8];
            const int tw0 = m0 + wave * 8;
            int lanev = tidv & 63; asm volatile("" : "+v"(lanev));
#pragma unroll
            for (int j = 0; j < 2; ++j) {
                const int c = 8 * lanev + 512 * j;
#pragma unroll
                for (int p = 1; p <= 2; ++p) {
                    float* dst = (p == 1) ? cx1[j] : cx2[j];
                    if (((tw0 & (SEQ - 1)) - p) >= 0) {
                        const u32x4 cvv = *(const u32x4*)(Z + (size_t)(tw0 - p) * DIN + 3 * DL + c);
                        dst[0] = bf_lo(cvv.x); dst[1] = bf_hi(cvv.x); dst[2] = bf_lo(cvv.y); dst[3] = bf_hi(cvv.y); dst[4] = bf_lo(cvv.z); dst[5] = bf_hi(cvv.z); dst[6] = bf_lo(cvv.w); dst[7] = bf_hi(cvv.w);
                    } else {
#pragma unroll
                        for (int e = 0; e < 8; ++e) dst[e] = 0.f;
                    }
                }
            }
#pragma unroll
            for (int tb = 0; tb < 8; tb += 4) {
                u32x4 zb[4][2], zc[4][2];
#pragma unroll
                for (int q = 0; q < 4; ++q)
#pragma unroll
                    for (int j = 0; j < 2; ++j) { const size_t mq = (size_t)(m0 + wave * 8 + tb + q); const int c = 8 * lanev + 512 * j;
                        zb[q][j] = *(const u32x4*)(Z + mq * DIN + 2 * DL + c); zc[q][j] = *(const u32x4*)(Z + mq * DIN + 3 * DL + c); }
#pragma unroll
                for (int qp = 0; qp < 4; ++qp) {
                    float yl[1][2][8], ys[1][2][8], sl[1] = {0.f}, s2[1] = {0.f};
#pragma unroll
                    for (int qq = 0; qq < 1; ++qq) {
                        const int q = qp + qq, t = wave * 8 + tb + q;
#pragma unroll
                        for (int j = 0; j < 2; ++j) {
                            const int c = 8 * lanev + 512 * j;
                            const u32x4 v = *(const LAS u32x4*)(lds + t * 2048 + c * 2);
                            yl[qq][j][0] = bf_lo(v.x); yl[qq][j][1] = bf_hi(v.x); yl[qq][j][2] = bf_lo(v.y); yl[qq][j][3] = bf_hi(v.y); yl[qq][j][4] = bf_lo(v.z); yl[qq][j][5] = bf_hi(v.z); yl[qq][j][6] = bf_lo(v.w); yl[qq][j][7] = bf_hi(v.w);
#pragma unroll
                            for (int e = 0; e < 8; ++e) sl[qq] += yl[qq][j][e] * yl[qq][j][e];
                            const u32x4 bv = zb[q][j], cvv = zc[q][j];
                            float cx0[8], bb[8], w0[8], w1[8], w2[8];
                            cx0[0] = bf_lo(cvv.x); cx0[1] = bf_hi(cvv.x); cx0[2] = bf_lo(cvv.y); cx0[3] = bf_hi(cvv.y); cx0[4] = bf_lo(cvv.z); cx0[5] = bf_hi(cvv.z); cx0[6] = bf_lo(cvv.w); cx0[7] = bf_hi(cvv.w);
                            bb[0] = bf_lo(bv.x); bb[1] = bf_hi(bv.x); bb[2] = bf_lo(bv.y); bb[3] = bf_hi(bv.y); bb[4] = bf_lo(bv.z); bb[5] = bf_hi(bv.z); bb[6] = bf_lo(bv.w); bb[7] = bf_hi(bv.w);
                            { const f32x4 a0 = *(const LAS f32x4*)(cst + 2 * DL + c), a1 = *(const LAS f32x4*)(cst + 2 * DL + c + 4), b0 = *(const LAS f32x4*)(cst + 3 * DL + c), b1 = *(const LAS f32x4*)(cst + 3 * DL + c + 4), c0 = *(const LAS f32x4*)(cst + 4 * DL + c), c1 = *(const LAS f32x4*)(cst + 4 * DL + c + 4);
#pragma unroll
                              for (int e = 0; e < 4; ++e) { w0[e] = a0[e]; w0[4 + e] = a1[e]; w1[e] = b0[e]; w1[4 + e] = b1[e]; w2[e] = c0[e]; w2[4 + e] = c1[e]; } }
#pragma unroll
                            for (int e = 0; e < 8; ++e) {
                                const float vv = bb[e] * (w0[e] * cx2[j][e] + w1[e] * cx1[j][e] + w2[e] * cx0[e]);
                                ys[qq][j][e] = vv; s2[qq] += vv * vv; cx2[j][e] = cx1[j][e]; cx1[j][e] = cx0[e];
                            }
                        }
                    }
#pragma unroll
                    for (int o = 1; o < 64; o <<= 1) { sl[0] += __shfl_xor(sl[0], o); s2[0] += __shfl_xor(s2[0], o); }
#pragma unroll
                    for (int qq = 0; qq < 1; ++qq) {
                        const size_t m = (size_t)(m0 + wave * 8 + tb + qp + qq);
                        const float rl = __builtin_amdgcn_rsqf(sl[qq] * (1.0f / DL) + EPS), rs = __builtin_amdgcn_rsqf(s2[qq] * (1.0f / DL) + EPS);
#pragma unroll
                        for (int j = 0; j < 2; ++j) {
                            const int c = 8 * lanev + 512 * j;
                            const f32x4 g0 = *(const LAS f32x4*)(cst + c), g1 = *(const LAS f32x4*)(cst + c + 4), k0 = *(const LAS f32x4*)(cst + DL + c), k1 = *(const LAS f32x4*)(cst + DL + c + 4);
                            u32x4 w; w.x = cvt_pk_bf16(yl[qq][j][0] * rl * g0[0], yl[qq][j][1] * rl * g0[1]); w.y = cvt_pk_bf16(yl[qq][j][2] * rl * g0[2], yl[qq][j][3] * rl * g0[3]);
                            w.z = cvt_pk_bf16(yl[qq][j][4] * rl * g1[0], yl[qq][j][5] * rl * g1[1]); w.w = cvt_pk_bf16(yl[qq][j][6] * rl * g1[2], yl[qq][j][7] * rl * g1[3]);
                            *(u32x4*)(Y + m * D + c) = w;
                            u32x4 w3; w3.x = cvt_pk_bf16(ys[qq][j][0] * rs * k0[0], ys[qq][j][1] * rs * k0[1]); w3.y = cvt_pk_bf16(ys[qq][j][2] * rs * k0[2], ys[qq][j][3] * rs * k0[3]);
                            w3.z = cvt_pk_bf16(ys[qq][j][4] * rs * k1[0], ys[qq][j][5] * rs * k1[1]); w3.w = cvt_pk_bf16(ys[qq][j][6] * rs * k1[2], ys[qq][j][7] * rs * k1[3]);
                            *(u32x4*)(Y + m * D + DL + c) = w3;
                        }
                    }
                }
            }
        }
        __syncthreads();
    }
    xcd_barrier(xbar); }
    for (int rep = 0, nrep = opaque_s(REP_[8]); rep < nrep; ++rep) {
    { pg8::Gemm g{Y, WOUT, M, D, D, D, D, 0}; pg8::StaticOrder S; S.init(M, D, G, (int)blockIdx.x); pg8::EpiResid E{nullptr, XB, XB, ss2, 1.0f};
      pg8::gemm_phase<pg8::EpiResid, EPI_ALIGN>(lds, g, S, E); }
    xcd_barrier(xbar); }
    for (int rep = 0, nrep = opaque_s(REP_[9]); rep < nrep; ++rep) {
    { pg8::Gemm g{XB, WGU, M, 2 * FF, D, D, D, 0}; pg8::StaticOrder S; S.init(M, 2 * FF, G, (int)blockIdx.x); pg8::EpiSwiglu E{HB, ss2};
      pg8::gemm_phase<pg8::EpiSwiglu, EPI_ALIGN>(lds, g, S, E); }
    xcd_barrier(xbar); }
    for (int rep = 0, nrep = opaque_s(REP_[10]); rep < nrep; ++rep) {
    { pg8::Gemm g{HB, WD, M, D, FF, FF, FF, 0}; pg8::StaticOrder S; S.init(M, D, G, (int)blockIdx.x); pg8::EpiResid E{nullptr, XB, XB, ss3, 0.5f};
      pg8::gemm_phase<pg8::EpiResid, EPI_ALIGN>(lds, g, S, E); }
    xcd_barrier(xbar); }
    {
        PHASE_IDS; const float* fg = args.in[22];
        for (int m0 = gw; m0 < M; m0 += 2 * NGW) {
            u32x4 v[2][4]; float r[2];
#pragma unroll
            for (int p = 0; p < 2; ++p) { const int m = (m0 + p * NGW < M) ? m0 + p * NGW : m0; r[p] = __builtin_amdgcn_rsqf(ss3[m] * (1.0f / D) + EPS); const u32x4* xi = (const u32x4*)(XB + (size_t)m * D) + lane;
#pragma unroll
                for (int j = 0; j < 4; ++j) v[p][j] = xi[64 * j]; }
#pragma unroll
            for (int p = 0; p < 2; ++p) { const int m = (m0 + p * NGW < M) ? m0 + p * NGW : m0; f32x4* o = (f32x4*)(out + (size_t)m * D) + 2 * lane; const f32x4* gg = (const f32x4*)fg + 2 * lane; const float rr = r[p];
#pragma unroll
                for (int j = 0; j < 4; ++j) { const f32x4 g0 = gg[128 * j], g1 = gg[128 * j + 1]; const u32x4 q = v[p][j];
                    __builtin_nontemporal_store((f32x4){bf_lo(q.x) * rr * g0[0], bf_hi(q.x) * rr * g0[1], bf_lo(q.y) * rr * g0[2], bf_hi(q.y) * rr * g0[3]}, o + 128 * j);
                    __builtin_nontemporal_store((f32x4){bf_lo(q.z) * rr * g1[0], bf_hi(q.z) * rr * g1[1], bf_lo(q.w) * rr * g1[2], bf_hi(q.w) * rr * g1[3]}, o + 128 * j + 1); } }
        }
    }
}

extern "C" void kernel_launch(void* const* d_in, const int* in_sizes, int n_in, void* d_out, int out_size, void* d_ws, size_t ws_size, hipStream_t stream) {
    static int grid = 0;
    if (grid == 0) {
        if (n_in != 23 || in_sizes[0] != M * D || out_size != M * D || ws_size < WS_END) { fprintf(stderr, "kernel_launch: unexpected shapes (n_in %d in0 %d out %d ws %zu)\n", n_in, n_in > 0 ? in_sizes[0] : -1, out_size, ws_size); grid = -1; return; }
        int dev = 0, cus = 0, per_cu = 0;
        (void)hipGetDevice(&dev); (void)hipDeviceGetAttribute(&cus, hipDeviceAttributeMultiprocessorCount, dev);
        (void)hipFuncSetAttribute((const void*)mega_fwd, hipFuncAttributeMaxDynamicSharedMemorySize, LDS_BYTES);
        if (hipOccupancyMaxActiveBlocksPerMultiprocessor(&per_cu, (const void*)mega_fwd, 512, LDS_BYTES) != hipSuccess || per_cu < 1) per_cu = 1;
        (void)hipGetLastError();
        grid = cus * per_cu;
    }
    if (grid < 0) return;
    if (hipMemsetAsync((char*)d_ws + WS_BAR, 0, BAR_BYTES, stream) != hipSuccess) { fprintf(stderr, "kernel_launch: memset of barrier words failed\n"); return; }
    Args a{};
    for (int i = 0; i < 23; ++i) a.in[i] = (const float*)d_in[i];
    a.out = (float*)d_out; a.ws = (unsigned char*)d_ws;
    void* kargs[] = {&a};
    hipError_t e = hipLaunchCooperativeKernel((const void*)mega_fwd, dim3(grid), dim3(512), kargs, LDS_BYTES, stream);
    if (e != hipSuccess) fprintf(stderr, "cooperative launch failed: %s (grid %d)\n", hipGetErrorString(e), grid);
}
```
